# Optimizing an MI355X kernel written in HIP

```python
import math
import jax
import jax.numpy as jnp
from jax import lax
import numpy as np

D_MODEL = 1024
BATCH = 8
SEQ = 4096
DEPTH = 2

CTX_LEN = 256
GRID_W = 64
EPS = 1e-6
ROPE_THETA = 10000.0
Q_BLOCK = 128
WINDOW = 128
NEG = -1e30

HA = 8
A_NOPE = 64
A_ROPE = 32
A_V = 64
A_Q_RANK = 256
A_KV_RANK = 128
HB = 8
HB_KV = 2
B_HD = 64
HC = 8
HC_KV = 2
C_HD = 64

BRANCH_W = 512
N_BRANCH = 3
D_FF = 2816
CONV_W = 3

IN_SIZES = (A_Q_RANK, A_KV_RANK, A_ROPE, HB * B_HD, HB_KV * B_HD, HB_KV * B_HD, HC * C_HD, HC_KV * C_HD, HC_KV * C_HD, N_BRANCH * D_MODEL)
IN_COLS = sum(IN_SIZES)

kernel_name = 'hybrid_mla_gqa_swa_convffn_trunk'


def rms_norm(x, g):
    xf = x.astype(jnp.float32)
    y = xf * lax.rsqrt(jnp.mean(xf * xf, axis=-1, keepdims=True) + EPS)
    return (y * g.astype(jnp.float32)).astype(x.dtype)


def modulate(x, g, shift, scale):
    return rms_norm(x, g) * (1 + scale) + shift


def axial_rope_table(rows, head_dim):
    n_freq = head_dim // 4
    row = jnp.repeat(jnp.arange(rows, dtype=jnp.float32), GRID_W)
    col = jnp.tile(jnp.arange(GRID_W, dtype=jnp.float32), rows)
    inv = ROPE_THETA ** (-jnp.arange(n_freq, dtype=jnp.float32) / n_freq)
    ang = jnp.stack([row[:, None] * inv, col[:, None] * inv], axis=1)
    return jnp.cos(ang), jnp.sin(ang)


def apply_rope(x, table):
    if table is None:
        return x
    cos, sin = table
    shp = x.shape
    nf = shp[-1] // 4
    xr = x.reshape(shp[:-1] + (2, 2, nf))
    bshape = (1, shp[1]) + (1,) * (x.ndim - 3) + (2, nf)
    c = cos.reshape(bshape).astype(x.dtype)
    s = sin.reshape(bshape).astype(x.dtype)
    x0 = xr[..., 0, :]
    x1 = xr[..., 1, :]
    return jnp.stack([x0 * c - x1 * s, x1 * c + x0 * s], axis=-2).reshape(shp)


def blocked_attention(q, k, v, scale, sink=None):
    b, lq, hkv, g, dk = q.shape
    nblk = lq // Q_BLOCK
    n_keys = k.shape[1]
    qb = q.reshape(b, nblk, Q_BLOCK, hkv, g, dk).transpose(1, 0, 2, 3, 4, 5)

    def one_block(qblk):
        s = jnp.einsum('bqhgd,bkhd->bhgqk', qblk, k).astype(jnp.float32) * scale
        if sink is not None:
            sk = jnp.broadcast_to(sink.astype(jnp.float32).reshape(1, hkv, g, 1, 1), s.shape[:-1] + (1,))
            s = jnp.concatenate([s, sk], axis=-1)
        p = jax.nn.softmax(s, axis=-1)[..., :n_keys].astype(v.dtype)
        return jnp.einsum('bhgqk,bkhd->bqhgd', p, v)

    out = lax.map(one_block, qb)
    return out.transpose(1, 0, 2, 3, 4, 5).reshape(b, lq, hkv * g * v.shape[-1])


def window_attention(q, k, v, k_ctx, v_ctx, sink, scale):
    b, n, hkv, g, d = q.shape
    nblk = n // Q_BLOCK
    n_ctx = k_ctx.shape[1]
    band = 3 * Q_BLOCK
    qb = q.reshape(b, nblk, Q_BLOCK, hkv, g, d).transpose(1, 0, 2, 3, 4, 5)

    def banded(t):
        tp = jnp.pad(t, ((0, 0), (Q_BLOCK, Q_BLOCK), (0, 0), (0, 0)))
        tp = tp.reshape(b, nblk + 2, Q_BLOCK, hkv, t.shape[-1])
        return jnp.concatenate([tp[:, :-2], tp[:, 1:-1], tp[:, 2:]], axis=2).transpose(1, 0, 2, 3, 4)

    kw = banded(k)
    vw = banded(v)
    blk = jnp.arange(nblk)[:, None, None]
    qi = jnp.arange(Q_BLOCK)[None, :, None]
    kj = jnp.arange(band)[None, None, :]
    rel = kj - qi
    j_abs = blk * Q_BLOCK - Q_BLOCK + kj
    valid = (rel >= Q_BLOCK - WINDOW) & (rel <= Q_BLOCK + WINDOW) & (j_abs >= 0) & (j_abs < n)
    sink_f = sink.astype(jnp.float32).reshape(1, hkv, g, 1, 1)

    def one_block(args):
        qblk, kblk, vblk, mask = args
        s_ctx = jnp.einsum('bqhgd,bkhd->bhgqk', qblk, k_ctx).astype(jnp.float32) * scale
        s_win = jnp.einsum('bqhgd,bkhd->bhgqk', qblk, kblk).astype(jnp.float32) * scale
        s_win = jnp.where(mask, s_win, NEG)
        s_sink = jnp.broadcast_to(sink_f, s_win.shape[:-1] + (1,))
        p = jax.nn.softmax(jnp.concatenate([s_ctx, s_win, s_sink], axis=-1), axis=-1).astype(v.dtype)
        return (jnp.einsum('bhgqk,bkhd->bqhgd', p[..., :n_ctx], v_ctx)
                + jnp.einsum('bhgqk,bkhd->bqhgd', p[..., n_ctx:n_ctx + band], vblk))

    out = lax.map(one_block, (qb, kw, vw, valid))
    return out.transpose(1, 0, 2, 3, 4, 5).reshape(b, n, hkv * g * v.shape[-1])


def project_mixers(h, w_in, b_gate, g_q_a, w_q_b, g_kv_a, w_kv_b, g_qn, g_kn, rope_a, rope_h):
    b, n, _ = h.shape
    cuts = []
    acc = 0
    for size in IN_SIZES[:-1]:
        acc += size
        cuts.append(acc)
    aq, akv, akr, bq, bk, bv, cq, ck, cv, gl = jnp.split(h @ w_in, cuts, axis=-1)
    q = (rms_norm(aq, g_q_a) @ w_q_b).reshape(b, n, HA, A_NOPE + A_ROPE)
    kv = (rms_norm(akv, g_kv_a) @ w_kv_b).reshape(b, n, HA, A_NOPE + A_V)
    k_rope = apply_rope(akr, rope_a)
    q_a = jnp.concatenate([q[..., :A_NOPE], apply_rope(q[..., A_NOPE:], rope_a)], axis=-1)[:, :, :, None, :]
    k_a = jnp.concatenate([kv[..., :A_NOPE], jnp.broadcast_to(k_rope[:, :, None, :], (b, n, HA, A_ROPE))], axis=-1)
    v_a = kv[..., A_NOPE:]
    q_b = apply_rope(rms_norm(bq.reshape(b, n, HB_KV, HB // HB_KV, B_HD), g_qn), rope_h)
    k_b = apply_rope(rms_norm(bk.reshape(b, n, HB_KV, B_HD), g_kn), rope_h)
    v_b = bv.reshape(b, n, HB_KV, B_HD)
    q_c = apply_rope(cq.reshape(b, n, HC_KV, HC // HC_KV, C_HD), rope_h)
    k_c = apply_rope(ck.reshape(b, n, HC_KV, C_HD), rope_h)
    v_c = cv.reshape(b, n, HC_KV, C_HD)
    gates = jax.nn.sigmoid(gl + b_gate).reshape(b, n, N_BRANCH, D_MODEL)
    return (q_a, k_a, v_a, q_b, k_b, v_b, q_c, k_c, v_c, gates)


def merge_branches(outs, gates, w_branch, w_out):
    y = sum(gates[:, :, i] * (o @ w_branch[i]) for i, o in enumerate(outs))
    return y @ w_out


def conv_ffn(h, w_up, w_conv, b_conv, w_down):
    n = h.shape[1]
    half = CONV_W // 2
    u = jnp.pad(h @ w_up, ((0, 0), (half, half), (0, 0)))
    u = sum(u[:, j:j + n] * w_conv[j] for j in range(CONV_W)) + b_conv
    a, gv = jnp.split(u, 2, axis=-1)
    return (jax.nn.silu(a) * gv) @ w_down


def setup_inputs(seed: int = 0) -> dict:
    key = jax.random.key(seed)
    ks = jax.random.split(key, 24)

    def nrm(k, shape, scale):
        return jax.random.normal(k, shape, jnp.float32) * scale

    def gain(k, shape):
        return 1.0 + 0.02 * jax.random.normal(k, shape, jnp.float32)

    return {
        'x': nrm(ks[0], (BATCH, SEQ, D_MODEL), 1.0),
        'c': nrm(ks[1], (BATCH, D_MODEL), 1.0),
        'ctx': nrm(ks[2], (BATCH, CTX_LEN, D_MODEL), 1.0),
        'c_ctx': nrm(ks[3], (D_MODEL,), 1.0),
        'w_mod': nrm(ks[4], (DEPTH, D_MODEL, 6 * D_MODEL), 0.5 * D_MODEL ** -0.5),
        'b_mod': nrm(ks[5], (DEPTH, 6 * D_MODEL), 0.01),
        'g_norm1': gain(ks[6], (DEPTH, D_MODEL)),
        'w_in': nrm(ks[7], (DEPTH, D_MODEL, IN_COLS), D_MODEL ** -0.5),
        'b_gate': nrm(ks[8], (DEPTH, N_BRANCH * D_MODEL), 0.02),
        'g_q_a': gain(ks[9], (DEPTH, A_Q_RANK)),
        'w_q_b': nrm(ks[10], (DEPTH, A_Q_RANK, HA * (A_NOPE + A_ROPE)), A_Q_RANK ** -0.5),
        'g_kv_a': gain(ks[11], (DEPTH, A_KV_RANK)),
        'w_kv_b': nrm(ks[12], (DEPTH, A_KV_RANK, HA * (A_NOPE + A_V)), A_KV_RANK ** -0.5),
        'g_qn': gain(ks[13], (DEPTH, B_HD)),
        'g_kn': gain(ks[14], (DEPTH, B_HD)),
        'sink': nrm(ks[15], (DEPTH, HC), 0.5),
        'w_branch': nrm(ks[16], (DEPTH, N_BRANCH, BRANCH_W, D_MODEL), BRANCH_W ** -0.5),
        'w_out': nrm(ks[17], (DEPTH, D_MODEL, D_MODEL), D_MODEL ** -0.5),
        'g_norm2': gain(ks[18], (DEPTH, D_MODEL)),
        'w_up': nrm(ks[19], (DEPTH, D_MODEL, 2 * D_FF), D_MODEL ** -0.5),
        'w_conv': nrm(ks[20], (DEPTH, CONV_W, 2 * D_FF), CONV_W ** -0.5),
        'b_conv': nrm(ks[21], (DEPTH, 2 * D_FF), 0.02),
        'w_down': nrm(ks[22], (DEPTH, D_FF, D_MODEL), D_FF ** -0.5),
        'g_final': gain(ks[23], (D_MODEL,)),
    }


def reference(x, c, ctx, c_ctx, w_mod, b_mod, g_norm1, w_in, b_gate, g_q_a, w_q_b, g_kv_a, w_kv_b, g_qn, g_kn, sink, w_branch, w_out, g_norm2, w_up, w_conv, b_conv, w_down, g_final):
    n = x.shape[1]
    rows = n // GRID_W
    rope_a = axial_rope_table(rows, A_ROPE)
    rope_h = axial_rope_table(rows, B_HD)
    scale_a = 1.0 / math.sqrt(A_NOPE + A_ROPE)
    scale_h = 1.0 / math.sqrt(B_HD)
    x_lat = x
    x_ctx = ctx
    for l in range(DEPTH):
        m_lat = jnp.split((jax.nn.silu(c) @ w_mod[l] + b_mod[l])[:, None, :], 6, axis=-1)
        m_ctx = jnp.split(jax.nn.silu(c_ctx) @ w_mod[l] + b_mod[l], 6, axis=-1)
        lw = (w_in[l], b_gate[l], g_q_a[l], w_q_b[l], g_kv_a[l], w_kv_b[l], g_qn[l], g_kn[l])
        qa, ka, va, qb, kb, vb, qc, kc, vc, gates = project_mixers(
            modulate(x_lat, g_norm1[l], m_lat[0], m_lat[1]), *lw, rope_a, rope_h)
        cqa, cka, cva, cqb, ckb, cvb, cqc, ckc, cvc, cgates = project_mixers(
            modulate(x_ctx, g_norm1[l], m_ctx[0], m_ctx[1]), *lw, None, None)
        o_a = blocked_attention(qa, jnp.concatenate([cka, ka], axis=1), jnp.concatenate([cva, va], axis=1), scale_a)
        o_b = blocked_attention(qb, jnp.concatenate([ckb, kb], axis=1), jnp.concatenate([cvb, vb], axis=1), scale_h)
        o_c = window_attention(qc, kc, vc, ckc, cvc, sink[l], scale_h)
        x_lat = x_lat + m_lat[2] * merge_branches((o_a, o_b, o_c), gates, w_branch[l], w_out[l])
        x_lat = x_lat + m_lat[5] * conv_ffn(modulate(x_lat, g_norm2[l], m_lat[3], m_lat[4]), w_up[l], w_conv[l], b_conv[l], w_down[l])
        if l < DEPTH - 1:
            co_a = blocked_attention(cqa, cka, cva, scale_a)
            co_b = blocked_attention(cqb, ckb, cvb, scale_h)
            co_c = blocked_attention(cqc, ckc, cvc, scale_h, sink[l])
            x_ctx = x_ctx + m_ctx[2] * merge_branches((co_a, co_b, co_c), cgates, w_branch[l], w_out[l])
            x_ctx = x_ctx + m_ctx[5] * conv_ffn(modulate(x_ctx, g_norm2[l], m_ctx[3], m_ctx[4]), w_up[l], w_conv[l], b_conv[l], w_down[l])
    return rms_norm(x_lat, g_final)
```

```cpp
#include <hip/hip_runtime.h>
#include <hip/hip_cooperative_groups.h>
#include <cstdio>
#include <cstdint>
namespace cg = cooperative_groups;
namespace pg8 {
#define PG8_LAS __attribute__((address_space(3)))
typedef unsigned short bf16_t;
typedef short bf16x8 __attribute__((ext_vector_type(8)));
typedef float f32x4 __attribute__((ext_vector_type(4)));
typedef unsigned u32x4 __attribute__((ext_vector_type(4)));
constexpr int BM = 256, BK = 64, HALF = 128, HTB = HALF * BK * 2  , STAGE_BYTES = 8 * HTB, NXCD = 8, WGM = 8;

__host__ __device__ __forceinline__ int lds_byte(int r, int c) { const int st = (r >> 4) * 2 + (c >> 5), rr = r & 15, cc = c & 31, ob = rr * 64 + cc * 2; return st * 1024 + (ob ^ (((ob >> 9) & 1) << 5)); }
__host__ __device__ __forceinline__ void stage_rc(int b, int& R, int& C) { const int st = b / 1024, sb = b % 1024, swz = sb ^ (((sb >> 9) & 1) << 5); R = (st >> 1) * 16 + swz / 64; C = (st & 1) * 32 + (swz % 64) / 2; }
__host__ __device__ __forceinline__ int perm32(int rho) { const int n = rho >> 4, i = rho & 15; return 8 * (i >> 2) + 4 * n + (i & 3); }

struct Unit { int pm, pn, z; };
struct Gemm { const bf16_t* A; const bf16_t* Bt; int M, N, K; size_t zA, zB; };
typedef float f32x2_cv __attribute__((ext_vector_type(2))); typedef __bf16 bf16x2_cv __attribute__((ext_vector_type(2)));
__device__ __forceinline__ unsigned cvt_pk_bf16(float lo, float hi) { f32x2_cv v = {lo, hi}; bf16x2_cv b = __builtin_convertvector(v, bf16x2_cv); return __builtin_bit_cast(unsigned, b); }
typedef float f32x2 __attribute__((ext_vector_type(2)));
template <class Epi, class Sched, bool ALIGN_EPI = false, bool SP2 = false>
__device__ __forceinline__ void gemm_phase(PG8_LAS unsigned char* lds, const Gemm g, const Sched& S, const Epi& E) {
    int tid_ = threadIdx.x; asm volatile("" : "+v"(tid_));
    const int tid = tid_, wid = __builtin_amdgcn_readfirstlane(tid >> 6), lane = tid & 63, wr = wid >> 2, wc = wid & 3, fr = lane & 15, fq = lane >> 4;
    const int K = g.K, nt = K / BK;
    unsigned voffA[2], voffB[2];
#pragma unroll
    for (int i = 0; i < 2; ++i) { int R, C; stage_rc(tid * 16 + i * 8192, R, C); const int Rb = Epi::PERM ? ((R & ~31) + perm32(R & 31)) : R;
        voffA[i] = (unsigned)(R * K + C) * 2u; voffB[i] = (unsigned)(Rb * K + C) * 2u; }
    const size_t kstep = (size_t)(BK * 2);
    const size_t hstep = (size_t)HALF * K * 2;
    const size_t tstep = 2 * hstep;
    const unsigned ldsw = (unsigned)wid * 1024u;
    const int aoff = lds_byte(wr * 64 + fr, fq * 8), boff = lds_byte(wc * 32 + fr, fq * 8);
#define PG8_SA(b, h) (((b) * 2 + (h)) * HTB)
#define PG8_SB(b, h) ((4 + (b) * 2 + (h)) * HTB)
#define PG8_STAGE(bufoff, gbase, voff) do { _Pragma("unroll") for (int _i = 0; _i < 2; ++_i) \
        __builtin_amdgcn_global_load_lds((const unsigned*)((const char*)(gbase) + (voff)[_i]), (PG8_LAS unsigned*)(lds + (bufoff) + ldsw + _i * 8192), 16, 0, 0); } while (0)
#define PG8_LDA(dst, b, h) do { _Pragma("unroll") for (int m = 0; m < 4; ++m) _Pragma("unroll") for (int k = 0; k < 2; ++k) dst[m][k] = *(const PG8_LAS bf16x8*)(lds + PG8_SA(b, h) + aoff + m * 2048 + k * 1024); } while (0)
#define PG8_LDB(dst, b, h) do { _Pragma("unroll") for (int n = 0; n < 2; ++n) _Pragma("unroll") for (int k = 0; k < 2; ++k) dst[n][k] = *(const PG8_LAS bf16x8*)(lds + PG8_SB(b, h) + boff + n * 2048 + k * 1024); } while (0)
#define PG8_MMA(ai, bj, At, Bt) do { __builtin_amdgcn_s_setprio(1); _Pragma("unroll") for (int m = 0; m < 4; ++m) _Pragma("unroll") for (int n = 0; n < 2; ++n) _Pragma("unroll") for (int k = 0; k < 2; ++k) \
        acc[ai][bj][m][n] = __builtin_amdgcn_mfma_f32_16x16x32_bf16(Bt[n][k], At[m][k], acc[ai][bj][m][n], 0, 0, 0); __builtin_amdgcn_s_setprio(0); } while (0)
#define PG8_WAIT_V(n) asm volatile("s_waitcnt vmcnt(" #n ")" ::: "memory")
#define PG8_WAIT_L(n) asm volatile("s_waitcnt lgkmcnt(" #n ")" ::: "memory")
#define PG8_BAR __builtin_amdgcn_s_barrier()
#define PG8_SCHED __builtin_amdgcn_sched_barrier(0)
    Unit cur, nxt; int ui = 0;
    if (!S.next(0, cur)) return;
    f32x4 acc[2][2][4][2];
#pragma unroll
    for (int a = 0; a < 2; ++a)
#pragma unroll
        for (int b = 0; b < 2; ++b)
#pragma unroll
            for (int m = 0; m < 4; ++m)
#pragma unroll
                for (int n = 0; n < 2; ++n) acc[a][b][m][n] = (f32x4){0.f, 0.f, 0.f, 0.f};
    bf16x8 At[4][2], B0[2][2], B1[2][2];
    const char* cA = (const char*)g.A + (size_t)cur.z * g.zA + (size_t)cur.pm * tstep; const char* cB = (const char*)g.Bt + (size_t)cur.z * g.zB + (size_t)cur.pn * tstep;
    S.a_ready(cur);
    if constexpr (SP2) {
        PG8_STAGE(PG8_SB(0, 0), cB, voffB); PG8_STAGE(PG8_SB(0, 1), cB + hstep, voffB); PG8_STAGE(PG8_SA(0, 0), cA, voffA); PG8_STAGE(PG8_SA(0, 1), cA + hstep, voffA);
        if (wr == 1) PG8_BAR;
        PG8_WAIT_V(2); PG8_BAR;
        PG8_STAGE(PG8_SB(1, 0), cB + kstep, voffB); PG8_STAGE(PG8_SA(1, 0), cA + kstep, voffA); PG8_STAGE(PG8_SB(1, 1), cB + hstep + kstep, voffB);
        PG8_WAIT_V(6); PG8_BAR;
    } else {
        PG8_STAGE(PG8_SB(0, 0), cB, voffB); PG8_STAGE(PG8_SA(0, 0), cA, voffA); PG8_STAGE(PG8_SB(0, 1), cB + hstep, voffB); PG8_STAGE(PG8_SA(0, 1), cA + hstep, voffA);
        if (wr == 1) PG8_BAR;
        PG8_WAIT_V(4); PG8_BAR;
        PG8_STAGE(PG8_SB(1, 0), cB + kstep, voffB); PG8_STAGE(PG8_SA(1, 0), cA + kstep, voffA); PG8_STAGE(PG8_SB(1, 1), cB + hstep + kstep, voffB);
        PG8_WAIT_V(6); PG8_BAR;
    }
    for (;;) {
        const bool has_next = S.next(ui + 1, nxt);
        const char* nA = has_next ? (const char*)g.A + (size_t)nxt.z * g.zA + (size_t)nxt.pm * tstep : cA; const char* nB = has_next ? (const char*)g.Bt + (size_t)nxt.z * g.zB + (size_t)nxt.pn * tstep : cB;
        for (int t = 0; t < nt; t += 2) {
            const bool last = (t == nt - 2);
            const char* a1 = cA + (size_t)(t + 1) * kstep;
            const char* a2 = last ? nA : cA + (size_t)(t + 2) * kstep; const char* b2 = last ? nB : cB + (size_t)(t + 2) * kstep;
            const char* a3 = a2 + kstep; const char* b3 = b2 + kstep;
            if (last && has_next) S.a_ready(nxt);
            if constexpr (SP2) {
            PG8_LDB(B0, 0, 0); PG8_LDB(B1, 0, 1); PG8_SCHED; PG8_LDA(At, 0, 0); PG8_STAGE(PG8_SA(1, 1), a1 + hstep, voffA);
            PG8_WAIT_V(8); PG8_WAIT_L(0); PG8_BAR; PG8_MMA(0, 0, At, B0); PG8_MMA(0, 1, At, B1); PG8_BAR; PG8_SCHED;
            PG8_LDA(At, 0, 1); PG8_STAGE(PG8_SB(0, 0), b2, voffB); PG8_STAGE(PG8_SB(0, 1), b2 + hstep, voffB); PG8_STAGE(PG8_SA(0, 0), a2, voffA);
            PG8_WAIT_V(8); PG8_WAIT_L(0); PG8_BAR; PG8_MMA(1, 0, At, B0); PG8_MMA(1, 1, At, B1); PG8_BAR; PG8_SCHED;
            PG8_LDB(B0, 1, 0); PG8_LDB(B1, 1, 1); PG8_SCHED; PG8_LDA(At, 1, 0); PG8_STAGE(PG8_SA(0, 1), a2 + hstep, voffA);
            PG8_WAIT_V(8); PG8_WAIT_L(0); PG8_BAR; PG8_MMA(0, 0, At, B0); PG8_MMA(0, 1, At, B1); PG8_BAR; PG8_SCHED;
            PG8_LDA(At, 1, 1); PG8_STAGE(PG8_SB(1, 0), b3, voffB); PG8_STAGE(PG8_SB(1, 1), b3 + hstep, voffB); PG8_STAGE(PG8_SA(1, 0), a3, voffA);
            PG8_WAIT_V(8); PG8_WAIT_L(0); PG8_BAR; PG8_MMA(1, 0, At, B0); PG8_MMA(1, 1, At, B1); PG8_BAR; PG8_SCHED;
            } else {
            PG8_LDB(B0, 0, 0); PG8_SCHED; PG8_LDA(At, 0, 0); PG8_STAGE(PG8_SA(1, 1), a1 + hstep, voffA);
            PG8_WAIT_L(8); PG8_BAR; PG8_WAIT_L(0); PG8_MMA(0, 0, At, B0); PG8_BAR; PG8_SCHED;
            PG8_LDB(B1, 0, 1); PG8_STAGE(PG8_SB(0, 0), b2, voffB);
            PG8_BAR; PG8_WAIT_L(0); PG8_MMA(0, 1, At, B1); PG8_BAR;
            PG8_LDA(At, 0, 1); PG8_STAGE(PG8_SA(0, 0), a2, voffA);
            PG8_BAR; PG8_WAIT_L(0); PG8_MMA(1, 0, At, B0); PG8_BAR; PG8_SCHED;
            PG8_STAGE(PG8_SB(0, 1), b2 + hstep, voffB);
            PG8_WAIT_V(6); PG8_BAR; PG8_MMA(1, 1, At, B1); PG8_BAR;
            PG8_LDB(B0, 1, 0); PG8_SCHED; PG8_LDA(At, 1, 0); PG8_STAGE(PG8_SA(0, 1), a2 + hstep, voffA);
            PG8_WAIT_L(8); PG8_BAR; PG8_WAIT_L(0); PG8_MMA(0, 0, At, B0); PG8_BAR; PG8_SCHED;
            PG8_LDB(B1, 1, 1); PG8_STAGE(PG8_SB(1, 0), b3, voffB);
            PG8_BAR; PG8_WAIT_L(0); PG8_MMA(0, 1, At, B1); PG8_BAR;
            PG8_LDA(At, 1, 1); PG8_STAGE(PG8_SA(1, 0), a3, voffA);
            PG8_BAR; PG8_WAIT_L(0); PG8_MMA(1, 0, At, B0); PG8_BAR; PG8_SCHED;
            PG8_STAGE(PG8_SB(1, 1), b3 + hstep, voffB);
            PG8_WAIT_V(6); PG8_BAR; PG8_MMA(1, 1, At, B1); PG8_BAR;
            }
        }
        if constexpr (ALIGN_EPI) { if (wr == 0) PG8_BAR; }
        if constexpr (!Epi::AFTER_DRAIN) { E(acc, cur, wr, wc, fr, fq); S.done(cur); }
        if (!has_next) break;
#pragma unroll
        for (int a = 0; a < 2; ++a)
#pragma unroll
            for (int b = 0; b < 2; ++b)
#pragma unroll
                for (int m = 0; m < 4; ++m)
#pragma unroll
                    for (int n = 0; n < 2; ++n) acc[a][b][m][n] = (f32x4){0.f, 0.f, 0.f, 0.f};
        cur = nxt; cA = nA; cB = nB; ++ui;
        if constexpr (ALIGN_EPI) { if (wr == 1) PG8_BAR; }
    }
    PG8_WAIT_V(0);
    if constexpr (!ALIGN_EPI) { if (wr == 0) PG8_BAR; }
    PG8_BAR;
    if constexpr (Epi::AFTER_DRAIN) { E.fused(acc, cur, wr, wc, fr, fq, lds, wid, lane); S.done(cur); }
#undef PG8_SA
#undef PG8_SB
#undef PG8_STAGE
#undef PG8_LDA
#undef PG8_LDB
#undef PG8_MMA
#undef PG8_WAIT_V
#undef PG8_WAIT_L
#undef PG8_BAR
#undef PG8_SCHED
}

struct TileSched {
    int nM, nN, nZ, ntiles, G, c, pm0, latonly;
    __device__ void init(int nM_, int nN_, int nZ_, int G_, int c_, int pm0_, int lat_ = 0) { nM = nM_; nN = nN_; nZ = nZ_; ntiles = nM_ * nN_; G = G_; c = c_; pm0 = pm0_; latonly = lat_; }
    __device__ bool next(int i, Unit& u) const {
        const int ti = i / nZ, z = i - ti * nZ; const long L = (long)ti * G + c; if (L >= ntiles) return false;
        int wgid = (int)L; { const int q = ntiles / NXCD, r = ntiles % NXCD, xcd = wgid % NXCD, off = wgid / NXCD; wgid = (xcd < r ? xcd * (q + 1) : r * (q + 1) + (xcd - r) * q) + off; }
        const int nig = WGM * nN, gid = wgid / nig, fm = gid * WGM, gsz = (nM - fm) < WGM ? (nM - fm) : WGM;
        int pm = pm0 + fm + ((wgid % nig) % gsz); if (latonly) pm = 17 * (pm >> 4) + 1 + (pm & 15);
        u.pm = pm; u.pn = (wgid % nig) / gsz; u.z = z; return true;
    }
    __device__ __forceinline__ void a_ready(const Unit&) const {}
    __device__ __forceinline__ void done(const Unit&) const {}
};
__device__ __forceinline__ float bf_lo(unsigned w) { return __builtin_bit_cast(float, w << 16); }
__device__ __forceinline__ float bf_hi(unsigned w) { return __builtin_bit_cast(float, w & 0xffff0000u); }
typedef unsigned u32x2 __attribute__((ext_vector_type(2)));
__device__ __forceinline__ float sigmoidf_(float x) { return __builtin_amdgcn_rcpf(1.0f + __builtin_amdgcn_exp2f(-1.4426950408889634f * x)); }

template <int ACT  > struct EpiStore {
    static constexpr bool PERM = true, AFTER_DRAIN = false;
    bf16_t* O; int ldc; const float* bias; int row_off;
    __device__ __forceinline__ void operator()(const f32x4 (&acc)[2][2][4][2], const Unit& u, int wr, int wc, int fr, int fq) const {
        const int row0 = u.pm * BM - row_off + wr * 64 + fr; const int col0 = u.pn * BM + wc * 32 + 8 * fq;
        f32x4 bv[2][2];
#pragma unroll
        for (int bj = 0; bj < 2; ++bj)
#pragma unroll
            for (int n = 0; n < 2; ++n) bv[bj][n] = (ACT == 2) ? *(const f32x4*)(bias + col0 + bj * HALF + 4 * n) : (f32x4){0.f, 0.f, 0.f, 0.f};
#pragma unroll
        for (int ai = 0; ai < 2; ++ai)
#pragma unroll
            for (int m = 0; m < 4; ++m) { bf16_t* rowp = O + (size_t)(row0 + ai * HALF + m * 16) * ldc + col0;
#pragma unroll
                for (int bj = 0; bj < 2; ++bj) { f32x4 v0 = acc[ai][bj][m][0] + bv[bj][0], v1 = acc[ai][bj][m][1] + bv[bj][1];
                    if (ACT == 2) {
                        unsigned q0[4], q1[4];
#pragma unroll
                        for (int e = 0; e < 4; ++e) { q0[e] = (unsigned)(sigmoidf_(v0[e]) * 255.f + 0.5f); q1[e] = (unsigned)(sigmoidf_(v1[e]) * 255.f + 0.5f); }
                        u32x2 w; w.x = q0[0] | (q0[1] << 8) | (q0[2] << 16) | (q0[3] << 24); w.y = q1[0] | (q1[1] << 8) | (q1[2] << 16) | (q1[3] << 24);
                        *(u32x2*)((unsigned char*)O + (size_t)(row0 + ai * HALF + m * 16) * ldc + col0 + bj * HALF) = w;
                    } else {
                    u32x4 w; w.x = cvt_pk_bf16(v0[0], v0[1]); w.y = cvt_pk_bf16(v0[2], v0[3]); w.z = cvt_pk_bf16(v1[0], v1[1]); w.w = cvt_pk_bf16(v1[2], v1[3]);
                    *(u32x4*)(rowp + bj * HALF) = w; } } }
    }
};
struct EpiBranch {
    static constexpr bool PERM = true, AFTER_DRAIN = false;
    bf16_t* Y; const bf16_t* G;
    __device__ __forceinline__ void operator()(const f32x4 (&acc)[2][2][4][2], const Unit& u, int wr, int wc, int fr, int fq) const {
        const int row0 = u.pm * BM + wr * 64 + fr; const int col0 = u.pn * BM + wc * 32 + 8 * fq; const int z = u.z;
#pragma unroll
        for (int ai = 0; ai < 2; ++ai)
#pragma unroll
            for (int m = 0; m < 4; ++m) { const size_t row = (size_t)(row0 + ai * HALF + m * 16);
#pragma unroll
                for (int bj = 0; bj < 2; ++bj) { const int col = col0 + bj * HALF;
                    const u32x2 gq = *(const u32x2*)((const unsigned char*)G + row * 3072 + z * 1024 + col); const float gs = 1.0f / 255.0f;
                    u32x4 yo = (u32x4){0u, 0u, 0u, 0u}; if (z) yo = *(const u32x4*)(Y + row * 1024 + col);
                    const f32x4 a0 = acc[ai][bj][m][0], a1 = acc[ai][bj][m][1];
                    u32x4 w;
                    w.x = cvt_pk_bf16(bf_lo(yo.x) + (float)(gq.x & 255u) * gs * a0[0], bf_hi(yo.x) + (float)((gq.x >> 8) & 255u) * gs * a0[1]);
                    w.y = cvt_pk_bf16(bf_lo(yo.y) + (float)((gq.x >> 16) & 255u) * gs * a0[2], bf_hi(yo.y) + (float)(gq.x >> 24) * gs * a0[3]);
                    w.z = cvt_pk_bf16(bf_lo(yo.z) + (float)(gq.y & 255u) * gs * a1[0], bf_hi(yo.z) + (float)((gq.y >> 8) & 255u) * gs * a1[1]);
                    w.w = cvt_pk_bf16(bf_lo(yo.w) + (float)((gq.y >> 16) & 255u) * gs * a1[2], bf_hi(yo.w) + (float)(gq.y >> 24) * gs * a1[3]);
                    *(u32x4*)(Y + row * 1024 + col) = w; }
                if (m & 1) asm volatile("" ::: "memory"); }
    }
};
struct EpiResid {
    static constexpr bool PERM = true, AFTER_DRAIN = false;
    const float* xin_lat; const float* xin_ctx; float* xo_lat; float* xo_ctx; const float* gate;
    __device__ __forceinline__ void operator()(const f32x4 (&acc)[2][2][4][2], const Unit& u, int wr, int wc, int fr, int fq) const {
        const int b = u.pm / 17, j = u.pm - b * 17;
        const float* xi = (j == 0) ? xin_ctx + (size_t)b * 256 * 1024 : xin_lat + ((size_t)b * 4096 + (size_t)(j - 1) * 256) * 1024;
        float* xo = (j == 0) ? xo_ctx + (size_t)b * 256 * 1024 : xo_lat + ((size_t)b * 4096 + (size_t)(j - 1) * 256) * 1024;
        const float* gv = gate + (size_t)((j == 0) ? 8 : b) * 6144;
        const int lr0 = wr * 64 + fr; const int col0 = u.pn * BM + wc * 32 + 8 * fq;
        f32x4 g[2][2];
#pragma unroll
        for (int bj = 0; bj < 2; ++bj)
#pragma unroll
            for (int n = 0; n < 2; ++n) g[bj][n] = *(const f32x4*)(gv + col0 + bj * HALF + 4 * n);
#pragma unroll
        for (int ai = 0; ai < 2; ++ai)
#pragma unroll
            for (int m = 0; m < 4; ++m) { const size_t off = (size_t)(lr0 + ai * HALF + m * 16) * 1024 + col0;
#pragma unroll
                for (int bj = 0; bj < 2; ++bj) {
                    const f32x4 x0 = *(const f32x4*)(xi + off + bj * HALF), x1 = *(const f32x4*)(xi + off + bj * HALF + 4);
                    *(f32x4*)(xo + off + bj * HALF) = x0 + g[bj][0] * acc[ai][bj][m][0];
                    *(f32x4*)(xo + off + bj * HALF + 4) = x1 + g[bj][1] * acc[ai][bj][m][1]; }
                if (m & 1) asm volatile("" ::: "memory"); }
    }
};
}

#define LAS __attribute__((address_space(3)))
typedef unsigned short bf16;
typedef unsigned v4u __attribute__((ext_vector_type(4)));
typedef unsigned v2u __attribute__((ext_vector_type(2)));
typedef float f32x4 __attribute__((ext_vector_type(4)));
typedef float f32x16 __attribute__((ext_vector_type(16)));
typedef short bf16x8 __attribute__((ext_vector_type(8)));
typedef short s16x4 __attribute__((ext_vector_type(4)));

constexpr int DM = 1024, NB = 8, SEQ = 4096, CTX = 256, TPB = SEQ + CTX, T = NB * TPB;
constexpr int NROWT = T / 256;
constexpr int DFF = 2816, NUP = 2 * DFF, INC = 5024, RW = 2048, QW = 1792, THALF = T / 2;
constexpr float EPS = 1e-6f, LOG2E = 1.4426950408889634f, L2_THETA = 13.287712379549449f;
constexpr int NWAVES = 8, LDS_BYTES = 147456;

constexpr size_t WS_MOD = 4096, WS_XCTX = 0x80000, WS_W = 0x880000;
constexpr size_t W_IN = 0, W_G = W_IN + (size_t)2048 * 1024 * 2, W_QKV = W_G + (size_t)3072 * 1024 * 2, W_BR = W_QKV + (size_t)1792 * 384 * 2,
                 W_OUT = W_BR + (size_t)3 * 1024 * 512 * 2, W_UP = W_OUT + (size_t)1024 * 1024 * 2, W_DN = W_UP + (size_t)NUP * 1024 * 2, W_END = W_DN + (size_t)1024 * DFF * 2;
constexpr size_t WS_DYN = WS_W + W_END;
constexpr size_t D_H = 0, D_R = D_H + (size_t)T * 1024 * 2, D_QKVA = D_R + (size_t)T * RW * 2, D_O = D_QKVA + (size_t)T * QW * 2, D_ATT_END = D_O + (size_t)3 * T * 512 * 2;
constexpr size_t D_U = D_R, D_ACT = D_U + (size_t)THALF * NUP * 2, D_FFN_END = D_ACT + (size_t)T * DFF * 2;
constexpr size_t WS_BAR = WS_DYN + (D_FFN_END > D_ATT_END ? D_FFN_END : D_ATT_END);
constexpr size_t WS_END = WS_BAR + 16384;
static_assert(WS_DYN % 256 == 0 && (size_t)T * 3072 * 2 <= D_O - D_R, "ws map");

struct Args {
    const float *x, *c, *ctx, *c_ctx, *w_mod, *b_mod, *g_norm1, *w_in, *b_gate, *g_q_a, *w_q_b, *g_kv_a, *w_kv_b, *g_qn, *g_kn, *sink, *w_branch, *w_out, *g_norm2, *w_up, *w_conv, *b_conv, *w_down, *g_final;
    float* out; unsigned char* ws; int ph_lo, ph_hi;
};

__device__ __forceinline__ unsigned f2bf(float f) { unsigned u = __builtin_bit_cast(unsigned, f); return (u + 0x7fffu + ((u >> 16) & 1u)) >> 16; }
__device__ __forceinline__ unsigned pk2(float lo, float hi) { return f2bf(lo) | (f2bf(hi) << 16); }
__device__ __forceinline__ float blo(unsigned w) { return __builtin_bit_cast(float, w << 16); }
__device__ __forceinline__ float bhi(unsigned w) { return __builtin_bit_cast(float, w & 0xffff0000u); }
__device__ __forceinline__ float wave_sum(float v) {
#pragma unroll
    for (int o = 1; o < 64; o <<= 1) v += __shfl_xor(v, o);
    return v;
}
#define LDS_WAIT() asm volatile("s_waitcnt lgkmcnt(0)" ::: "memory")

__device__ __forceinline__ void conv_item(const float* W, int ldw, int ncol0, bf16* WT, int ldt, int drow0, int dk0, int kb, int nb, LAS float* scr, int lane) {
    const int k0 = 64 * kb, n0 = 32 * nb;
#pragma unroll 8
    for (int i = 0; i < 32; ++i) { const int kk = 2 * i + (lane >> 5); scr[kk * 33 + (lane & 31)] = W[(size_t)(k0 + kk) * ldw + ncol0 + n0 + (lane & 31)]; }
    LDS_WAIT(); asm volatile("" ::: "memory");
    const int c = lane & 7;
#pragma unroll
    for (int j = 0; j < 4; ++j) { const int n = (lane >> 3) + 8 * j; const LAS float* s = scr + (8 * c) * 33 + n;
        v4u o; o.x = pk2(s[0 * 33], s[1 * 33]); o.y = pk2(s[2 * 33], s[3 * 33]); o.z = pk2(s[4 * 33], s[5 * 33]); o.w = pk2(s[6 * 33], s[7 * 33]);
        *(v4u*)(WT + (size_t)(drow0 + n0 + n) * ldt + dk0 + k0 + 8 * c) = o; }
    LDS_WAIT(); asm volatile("" ::: "memory");
}
__device__ __forceinline__ void convert_weights(const Args& a, int l, LAS unsigned char* lds, int G) {
    const int tid = threadIdx.x, lane = tid & 63, wave = tid >> 6;
    unsigned char* wb = a.ws + WS_W;
    bf16* WIN = (bf16*)(wb + W_IN); bf16* WG = (bf16*)(wb + W_G); bf16* WQKV = (bf16*)(wb + W_QKV); bf16* WBR = (bf16*)(wb + W_BR);
    bf16* WOUT = (bf16*)(wb + W_OUT); bf16* WUP = (bf16*)(wb + W_UP); bf16* WDN = (bf16*)(wb + W_DN);
    LAS float* scr = (LAS float*)(lds + wave * 16384);
    const int gw = blockIdx.x * NWAVES + wave, NGW = G * NWAVES;
    constexpr int I1 = 16 * 61, I2 = 16 * 96, I3 = 4 * 24, I4 = 2 * 32, I5 = 8 * 32, I6 = 16 * 32, I7 = 16 * 176, I8 = 44 * 32;
    constexpr int NIT = I1 + I2 + I3 + I4 + 3 * I5 + I6 + I7 + I8;
    const float* w_in = a.w_in + (size_t)l * 1024 * INC;
    for (int it = gw; it < NIT; it += NGW) {
        int r = it;
        if (r < I1) { conv_item(w_in, INC, 0, WIN, 1024, 0, 0, r / 61, r % 61, scr, lane); continue; } r -= I1;
        if (r < I2) { conv_item(w_in, INC, 1952, WG, 1024, 0, 0, r / 96, r % 96, scr, lane); continue; } r -= I2;
        if (r < I3) { conv_item(a.w_q_b + (size_t)l * 256 * 768, 768, 0, WQKV, 384, 0, 0, r / 24, r % 24, scr, lane); continue; } r -= I3;
        if (r < I4) { conv_item(a.w_kv_b + (size_t)l * 128 * 1024, 1024, 0, WQKV, 384, 768, 256, r / 32, r % 32, scr, lane); continue; } r -= I4;
        if (r < 3 * I5) { const int i = r / I5; r -= i * I5; conv_item(a.w_branch + ((size_t)l * 3 + i) * 512 * 1024, 1024, 0, WBR + (size_t)i * 1024 * 512, 512, 0, 0, r / 32, r % 32, scr, lane); continue; } r -= 3 * I5;
        if (r < I6) { conv_item(a.w_out + (size_t)l * 1024 * 1024, 1024, 0, WOUT, 1024, 0, 0, r / 32, r % 32, scr, lane); continue; } r -= I6;
        if (r < I7) { conv_item(a.w_up + (size_t)l * 1024 * NUP, NUP, 0, WUP, 1024, 0, 0, r / 176, r % 176, scr, lane); continue; } r -= I7;
        conv_item(a.w_down + (size_t)l * DFF * 1024, 1024, 0, WDN, DFF, 0, 0, r / 32, r % 32, scr, lane);
    }
    const int gt = blockIdx.x * 512 + tid, NGT = G * 512; const v4u z4 = (v4u){0u, 0u, 0u, 0u};
    for (int i = gt; i < 12288 + 12288 + 32768; i += NGT) {
        if (i < 12288) { *(v4u*)(WIN + (size_t)1952 * 1024 + (size_t)i * 8) = z4; }
        else if (i < 24576) { const int j = i - 12288; *(v4u*)(WQKV + (size_t)(j >> 4) * 384 + 256 + (j & 15) * 8) = z4; }
        else { const int j = i - 24576; *(v4u*)(WQKV + (size_t)(768 + (j >> 5)) * 384 + (j & 31) * 8) = z4; }
    }
}
__device__ __forceinline__ float siluf_(float x) { return x / (1.0f + __expf(-x)); }
__device__ __forceinline__ void mod_gemv(const Args& a, LAS unsigned char* lds, int G) {
    const int tid = threadIdx.x, lane = tid & 63, wave = tid >> 6;
    float* MOD = (float*)(a.ws + WS_MOD);
    LAS float* sl = (LAS float*)lds;
    LAS float* red = (LAS float*)(lds + 40960);
    if ((int)blockIdx.x < 192) {
        for (int i = tid; i < 9 * 1024; i += 512) { const float v = (i < 8192) ? a.c[i] : a.c_ctx[i - 8192]; sl[i] = siluf_(v); }
        __syncthreads();
    }
    for (int item = blockIdx.x; item < 192; item += G) {
        const int l = item / 96, n0 = (item % 96) * 64;
        float acc[9];
#pragma unroll
        for (int r = 0; r < 9; ++r) acc[r] = 0.f;
        const float* wp = a.w_mod + ((size_t)l * 1024 + wave * 128) * 6144 + n0 + lane;
#pragma unroll 8
        for (int k = 0; k < 128; ++k) {
            const float w = wp[(size_t)k * 6144]; const int kk = wave * 128 + k;
#pragma unroll
            for (int r = 0; r < 9; ++r) acc[r] += sl[r * 1024 + kk] * w;
        }
#pragma unroll
        for (int r = 0; r < 9; ++r) red[(wave * 9 + r) * 64 + lane] = acc[r];
        __syncthreads();
        for (int idx = tid; idx < 576; idx += 512) { const int r = idx >> 6, ln = idx & 63; float s = a.b_mod[l * 6144 + n0 + ln];
#pragma unroll
            for (int w = 0; w < 8; ++w) s += red[(w * 9 + r) * 64 + ln];
            MOD[((size_t)l * 9 + r) * 6144 + n0 + ln] = s; }
        __syncthreads();
    }
}

__device__ __forceinline__ void modulate_rows(const float* x_lat, const float* x_ctx, const float* gn, const float* mod_l, int sel_shift, int sel_scale, bf16* H, int G) {
    const int tid = threadIdx.x, lane = tid & 63, wave = tid >> 6; const int gw = blockIdx.x * NWAVES + wave, NGW = G * NWAVES;
    constexpr int NR = 4;
    for (int tok0 = gw; tok0 < T; tok0 += NR * NGW) {
        int tk[NR]; const float* xr[NR]; const float* mr[NR]; f32x4 v[NR][4]; float ss[NR];
#pragma unroll
        for (int u = 0; u < NR; ++u) { const int t_ = tok0 + u * NGW; tk[u] = (t_ < T) ? t_ : -1; const int tok = (t_ < T) ? t_ : tok0;
            const int b = tok / TPB, p = tok - b * TPB;
            xr[u] = (p < CTX) ? x_ctx + ((size_t)b * CTX + p) * DM : x_lat + ((size_t)b * SEQ + (p - CTX)) * DM;
            mr[u] = mod_l + (size_t)((p < CTX) ? 8 : b) * 6144; }
#pragma unroll
        for (int u = 0; u < NR; ++u)
#pragma unroll
            for (int j = 0; j < 4; ++j) v[u][j] = __builtin_nontemporal_load((const f32x4*)(xr[u] + 4 * lane + 256 * j));
#pragma unroll
        for (int u = 0; u < NR; ++u) { float s = 0.f;
#pragma unroll
            for (int j = 0; j < 4; ++j) s += (v[u][j].x * v[u][j].x + v[u][j].y * v[u][j].y) + (v[u][j].z * v[u][j].z + v[u][j].w * v[u][j].w);
            ss[u] = rsqrtf(wave_sum(s) * (1.f / DM) + EPS); }
#pragma unroll
        for (int j = 0; j < 4; ++j) { const int c = 4 * lane + 256 * j; const f32x4 g = *(const f32x4*)(gn + c);
#pragma unroll
            for (int u = 0; u < NR; ++u) if (tk[u] >= 0) { const f32x4 sh = *(const f32x4*)(mr[u] + sel_shift * 1024 + c), sc = *(const f32x4*)(mr[u] + sel_scale * 1024 + c);
                const f32x4 y = (v[u][j] * ss[u] * g) * (sc + 1.0f) + sh; v2u o; o.x = pk2(y.x, y.y); o.y = pk2(y.z, y.w); *(v2u*)(H + (size_t)tk[u] * DM + c) = o; } }
    }
}
__device__ __forceinline__ void head_pass(bf16* base, int nheads, bool norm, const float* gain, float oscale, bool lat, float prow, float pcol, int lane) {
    const int hd = lane >> 3, sub = lane & 7, axis = sub >> 2, fg = sub & 3; const bool active = hd < nheads;
    bf16* p0 = base + hd * 64 + axis * 32 + 4 * fg; bf16* p1 = p0 + 16;
    float x0[4] = {0.f, 0.f, 0.f, 0.f}, x1[4] = {0.f, 0.f, 0.f, 0.f};
    if (active) { const v2u a = *(const v2u*)p0, b = *(const v2u*)p1; x0[0] = blo(a.x); x0[1] = bhi(a.x); x0[2] = blo(a.y); x0[3] = bhi(a.y); x1[0] = blo(b.x); x1[1] = bhi(b.x); x1[2] = blo(b.y); x1[3] = bhi(b.y); }
    if (norm) {
        float ss = 0.f;
#pragma unroll
        for (int i = 0; i < 4; ++i) ss += x0[i] * x0[i] + x1[i] * x1[i];
        ss += __shfl_xor(ss, 1); ss += __shfl_xor(ss, 2); ss += __shfl_xor(ss, 4);
        const float rstd = rsqrtf(ss * (1.f / 64.f) + EPS);
#pragma unroll
        for (int i = 0; i < 4; ++i) { x0[i] *= rstd * gain[axis * 32 + 4 * fg + i]; x1[i] *= rstd * gain[axis * 32 + 16 + 4 * fg + i]; }
    }
    if (lat) { const float pos = axis ? pcol : prow;
#pragma unroll
        for (int i = 0; i < 4; ++i) { const float inv = __builtin_amdgcn_exp2f(-(float)(4 * fg + i) * (L2_THETA / 16.f)); const float ang = pos * inv, cs = __cosf(ang), sn = __sinf(ang);
            const float y0 = x0[i] * cs - x1[i] * sn, y1 = x1[i] * cs + x0[i] * sn; x0[i] = y0; x1[i] = y1; } }
    if (active) { v2u a, b; a.x = pk2(x0[0] * oscale, x0[1] * oscale); a.y = pk2(x0[2] * oscale, x0[3] * oscale); b.x = pk2(x1[0] * oscale, x1[1] * oscale); b.y = pk2(x1[2] * oscale, x1[3] * oscale);
        *(v2u*)p0 = a; *(v2u*)p1 = b; }
}
__device__ __forceinline__ void post_proj_rows(const Args& a, int l, bf16* R, bf16* AQKV, int G) {
    const int tid = threadIdx.x, lane = tid & 63, wave = tid >> 6; const int gw = blockIdx.x * NWAVES + wave, NGW = G * NWAVES;
    const float qs = 0.125f * LOG2E;
    for (int tok = gw; tok < T; tok += NGW) {
        const int b = tok / TPB, p = tok - b * TPB; const bool lat = p >= CTX; const int n = p - CTX; const float prow = (float)(n >> 6), pcol = (float)(n & 63);
        bf16* Rr = R + (size_t)tok * RW; bf16* Ar = AQKV + (size_t)tok * 384;
        { const v2u w = *(const v2u*)(Rr + 4 * lane); const float f0 = blo(w.x), f1 = bhi(w.x), f2 = blo(w.y), f3 = bhi(w.y);
          const float rstd = rsqrtf(wave_sum(f0 * f0 + f1 * f1 + f2 * f2 + f3 * f3) * (1.f / 256.f) + EPS);
          const f32x4 g = *(const f32x4*)(a.g_q_a + l * 256 + 4 * lane);
          v2u o; o.x = pk2(f0 * rstd * g.x, f1 * rstd * g.y); o.y = pk2(f2 * rstd * g.z, f3 * rstd * g.w); *(v2u*)(Ar + 4 * lane) = o; }
        { const unsigned w = *(const unsigned*)(Rr + 256 + 2 * lane); const float f0 = blo(w), f1 = bhi(w);
          const float rstd = rsqrtf(wave_sum(f0 * f0 + f1 * f1) * (1.f / 128.f) + EPS);
          const float g0 = a.g_kv_a[l * 128 + 2 * lane], g1 = a.g_kv_a[l * 128 + 2 * lane + 1];
          *(unsigned*)(Ar + 256 + 2 * lane) = pk2(f0 * rstd * g0, f1 * rstd * g1); }
        if (lat && lane < 16) { const int axis = lane >> 3, f = lane & 7; bf16* q0 = Rr + 384 + axis * 16 + f; bf16* q1 = q0 + 8;
          const float x0 = blo((unsigned)*q0), x1 = blo((unsigned)*q1); const float pos = axis ? pcol : prow;
          const float inv = __builtin_amdgcn_exp2f(-(float)f * (L2_THETA / 8.f)); const float ang = pos * inv, cs = __cosf(ang), sn = __sinf(ang);
          *q0 = (bf16)f2bf(x0 * cs - x1 * sn); *q1 = (bf16)f2bf(x1 * cs + x0 * sn); }
        head_pass(Rr + 416, 8, true, a.g_qn + l * 64, qs, lat, prow, pcol, lane);
        head_pass(Rr + 928, 2, true, a.g_kn + l * 64, 1.f, lat, prow, pcol, lane);
        head_pass(Rr + 1184, 8, false, nullptr, qs, lat, prow, pcol, lane);
        head_pass(Rr + 1696, 2, false, nullptr, 1.f, lat, prow, pcol, lane);
    }
}
__device__ __forceinline__ void conv_act(const Args& a, int l, int half, const bf16* U, bf16* ACT, int G) {
    const int gt = blockIdx.x * 512 + threadIdx.x, NGT = G * 512;
    const float* wc = a.w_conv + (size_t)l * 3 * NUP; const float* bc = a.b_conv + (size_t)l * NUP;
    constexpr int NCG = DFF / 8, NRUN = THALF / 32;
    for (int item = gt; item < NRUN * NCG; item += NGT) {
        const int run = item / NCG, cgp = item - run * NCG, c = 8 * cgp;
        const int lrow0 = run * 32, tok0 = half * THALF + lrow0; const int p = tok0 % TPB;
        const bool first = (p == 0) || (p == CTX); const bool lastrun = (p + 32 == CTX) || (p + 32 == TPB);
        float wa[3][8], wg[3][8], ba[8], bg[8];
#pragma unroll
        for (int j = 0; j < 3; ++j) { const f32x4 t0 = *(const f32x4*)(wc + j * NUP + c), t1 = *(const f32x4*)(wc + j * NUP + c + 4), t2 = *(const f32x4*)(wc + j * NUP + DFF + c), t3 = *(const f32x4*)(wc + j * NUP + DFF + c + 4);
#pragma unroll
            for (int e = 0; e < 4; ++e) { wa[j][e] = t0[e]; wa[j][4 + e] = t1[e]; wg[j][e] = t2[e]; wg[j][4 + e] = t3[e]; } }
        { const f32x4 t0 = *(const f32x4*)(bc + c), t1 = *(const f32x4*)(bc + c + 4), t2 = *(const f32x4*)(bc + DFF + c), t3 = *(const f32x4*)(bc + DFF + c + 4);
#pragma unroll
            for (int e = 0; e < 4; ++e) { ba[e] = t0[e]; ba[4 + e] = t1[e]; bg[e] = t2[e]; bg[4 + e] = t3[e]; } }
        const v4u z4 = (v4u){0u, 0u, 0u, 0u};
        const bf16* up = U + (size_t)lrow0 * NUP + c;
        v4u pa = z4, pg = z4; if (!first) { pa = __builtin_nontemporal_load((const v4u*)(up - NUP)); pg = __builtin_nontemporal_load((const v4u*)(up - NUP + DFF)); }
        v4u ca = __builtin_nontemporal_load((const v4u*)up), cgv = __builtin_nontemporal_load((const v4u*)(up + DFF));
        for (int i = 0; i < 32; ++i) {
            v4u na = z4, ng = z4; if (!(lastrun && i == 31)) { na = __builtin_nontemporal_load((const v4u*)(up + (size_t)(i + 1) * NUP)); ng = __builtin_nontemporal_load((const v4u*)(up + (size_t)(i + 1) * NUP + DFF)); }
            v4u o;
#pragma unroll
            for (int e = 0; e < 4; ++e) {
                const float a0 = blo(pa[e]) * wa[0][2 * e] + blo(ca[e]) * wa[1][2 * e] + blo(na[e]) * wa[2][2 * e] + ba[2 * e];
                const float a1 = bhi(pa[e]) * wa[0][2 * e + 1] + bhi(ca[e]) * wa[1][2 * e + 1] + bhi(na[e]) * wa[2][2 * e + 1] + ba[2 * e + 1];
                const float g0 = blo(pg[e]) * wg[0][2 * e] + blo(cgv[e]) * wg[1][2 * e] + blo(ng[e]) * wg[2][2 * e] + bg[2 * e];
                const float g1 = bhi(pg[e]) * wg[0][2 * e + 1] + bhi(cgv[e]) * wg[1][2 * e + 1] + bhi(ng[e]) * wg[2][2 * e + 1] + bg[2 * e + 1];
                o[e] = pk2(siluf_(a0) * g0, siluf_(a1) * g1);
            }
            *(v4u*)(ACT + (size_t)(tok0 + i) * DFF + c) = o;
            pa = ca; pg = cgv; ca = na; cgv = ng;
        }
    }
}
__device__ __forceinline__ void final_norm(const Args& a, int G) {
    const int tid = threadIdx.x, lane = tid & 63, wave = tid >> 6; const int gw = blockIdx.x * NWAVES + wave, NGW = G * NWAVES;
    for (int row0 = gw; row0 < NB * SEQ; row0 += 2 * NGW) {
        const int rowB = (row0 + NGW < NB * SEQ) ? row0 + NGW : row0; const bool two = rowB != row0;
        float* xA = a.out + (size_t)row0 * DM; float* xB = a.out + (size_t)rowB * DM;
        f32x4 vA[4], vB[4]; float sA = 0.f, sB = 0.f;
#pragma unroll
        for (int j = 0; j < 4; ++j) vA[j] = __builtin_nontemporal_load((const f32x4*)(xA + 4 * lane + 256 * j));
#pragma unroll
        for (int j = 0; j < 4; ++j) vB[j] = __builtin_nontemporal_load((const f32x4*)(xB + 4 * lane + 256 * j));
#pragma unroll
        for (int j = 0; j < 4; ++j) { sA += (vA[j].x * vA[j].x + vA[j].y * vA[j].y) + (vA[j].z * vA[j].z + vA[j].w * vA[j].w); sB += (vB[j].x * vB[j].x + vB[j].y * vB[j].y) + (vB[j].z * vB[j].z + vB[j].w * vB[j].w); }
        const float rA = rsqrtf(wave_sum(sA) * (1.f / DM) + EPS), rB = rsqrtf(wave_sum(sB) * (1.f / DM) + EPS);
#pragma unroll
        for (int j = 0; j < 4; ++j) { const int c = 4 * lane + 256 * j; const f32x4 g = *(const f32x4*)(a.g_final + c);
            __builtin_nontemporal_store(vA[j] * rA * g, (f32x4*)(xA + c));
            if (two) __builtin_nontemporal_store(vB[j] * rB * g, (f32x4*)(xB + c)); }
    }
}
#define XB_TMO      128
#define XB_XCNT(j)  (256  + 64 * (j))
#define XB_XSUB(j)  (1280 + 64 * (j))
#define XB_XGEN(j)  (2304 + 64 * (j))
#define XB_TOP      3328
#define XB_TOPGEN   3392
#define XCD_BAR_WORDS 3456
#define XB_SPIN_CAP (1u << 18)

__device__ __forceinline__ unsigned xb_ld(unsigned* p)              { return __hip_atomic_load(p, __ATOMIC_RELAXED, __HIP_MEMORY_SCOPE_AGENT); }
__device__ __forceinline__ unsigned xb_add(unsigned* p, unsigned v) { return __hip_atomic_fetch_add(p, v, __ATOMIC_RELAXED, __HIP_MEMORY_SCOPE_AGENT); }
__device__ __forceinline__ unsigned xb_xcc_id() { return (unsigned)__builtin_amdgcn_s_getreg((3 << 11) | 20) & 0xFu; }
#define XB_SPIN(cond, bar) do { unsigned _sp = 0; while (cond) { __builtin_amdgcn_s_sleep(1); \
    if ((++_sp & 255u) == 0u) { if (xb_ld(&(bar)[XB_TMO])) break; if (_sp > XB_SPIN_CAP) { atomicAdd(&(bar)[XB_TMO], 1u); break; } } } } while (0)

struct XcdBarrier {
    unsigned* bar; unsigned x;
    volatile LAS unsigned* st;
};

__device__ __forceinline__ XcdBarrier xcd_barrier_post(unsigned* bar, volatile LAS unsigned* st) {
    XcdBarrier b; b.bar = bar; b.x = xb_xcc_id(); b.st = st;
    if (threadIdx.x == 0) (void)xb_add(&bar[XB_XCNT(b.x)], 1u);
    return b;
}
__device__ __forceinline__ void xcd_barrier_complete(unsigned* bar, unsigned x, unsigned& nloc, unsigned& nx) {
    const unsigned G = gridDim.x * gridDim.y * gridDim.z;
    unsigned sum, cnt, mine, sp = 0u;
    for (;;) {
        sum = 0u; cnt = 0u; mine = 0u;
#pragma unroll
        for (unsigned j = 0; j < 16; ++j) { const unsigned c = xb_ld(&bar[XB_XCNT(j)]); sum += c; cnt += (c > 0u) ? 1u : 0u; mine = (j == x) ? c : mine; }
        if (sum == G) break;
        __builtin_amdgcn_s_sleep(1);
        if ((++sp & 255u) == 0u) { if (xb_ld(&bar[XB_TMO])) break; if (sp > XB_SPIN_CAP) { atomicAdd(&bar[XB_TMO], 1u); break; } }
    }
    nloc = mine > 0u ? mine : 1u; nx = cnt > 0u ? cnt : 1u;
}

__device__ __forceinline__ void xcd_barrier(const XcdBarrier& b) {
    asm volatile("s_waitcnt vmcnt(0)" ::: "memory");
    __syncthreads();
    if (threadIdx.x == 0) {
        unsigned* bar = b.bar;
        __builtin_amdgcn_s_waitcnt(0);
        unsigned nloc = b.st[0], nx = b.st[1];
        if (nloc == 0u) { xcd_barrier_complete(bar, b.x, nloc, nx); b.st[0] = nloc; b.st[1] = nx; }
        const unsigned old = xb_add(&bar[XB_XSUB(b.x)], 1u);
        const unsigned gen = old / nloc;
        if (old + 1u == (gen + 1u) * nloc) {
            __builtin_amdgcn_fence(__ATOMIC_RELEASE, "agent");
            asm volatile("s_waitcnt vmcnt(0)" ::: "memory");
            const unsigned og = xb_add(&bar[XB_TOP], 1u);
            const unsigned tg = og / nx;
            if (og + 1u == (tg + 1u) * nx) xb_add(&bar[XB_TOPGEN], 1u);
            else XB_SPIN(xb_ld(&bar[XB_TOPGEN]) == tg, bar);
            __builtin_amdgcn_fence(__ATOMIC_ACQUIRE, "agent");
            xb_add(&bar[XB_XGEN(b.x)], 1u);
            asm volatile("s_waitcnt vmcnt(0)" ::: "memory");
        } else {
            XB_SPIN(xb_ld(&bar[XB_XGEN(b.x)]) == gen, bar);
            __builtin_amdgcn_fence(__ATOMIC_ACQUIRE, "agent");
            asm volatile("s_waitcnt vmcnt(0)" ::: "memory");
        }
    }
    __syncthreads();
}

__device__ __forceinline__ int crow(int r, int hi) { return (r & 3) + 8 * (r >> 2) + 4 * hi; }
typedef short v4i16_t __attribute__((ext_vector_type(4)));
__device__ __forceinline__ s16x4 vtr(const LAS unsigned char* p) { return __builtin_bit_cast(s16x4, __builtin_amdgcn_ds_read_tr16_b64_v4i16((LAS v4i16_t*)p)); }
__device__ __forceinline__ unsigned cvtpk(float lo, float hi) { return pg8::cvt_pk_bf16(lo, hi); }

template <int MIX>
__device__ __forceinline__ void attn_unit(LAS unsigned char* lds, const bf16* R, const bf16* QKVA, bf16* Oall, const float* sink, int b, int h, int qb) {
    constexpr int DK = (MIX == 0) ? 96 : 64, ND = DK / 16, KCH = DK / 8;
    constexpr int KSTR = DK * 2 + 16, VSTR = 192, KBUF = 64 * KSTR, VBUF = 64 * VSTR;
    int tid_ = threadIdx.x; asm volatile("" : "+v"(tid_));
    const int tid = tid_, lane = tid & 63, wid = tid >> 6, r32 = lane & 31, hi = lane >> 5;
    const bool isctx = qb < 0;
    const int p0 = isctx ? 0 : CTX + 256 * qb;
    const size_t tokb = (size_t)b * TPB;
    const size_t qtok = tokb + p0 + wid * 32 + r32;
    const int nq = p0 - CTX + wid * 32 + r32;
    bf16x8 qr[ND];
    if (MIX == 0) {
        const bf16* qp = QKVA + qtok * QW + h * 96;
        const float qs = 0.10206207261596575f * LOG2E;
#pragma unroll
        for (int d0 = 0; d0 < ND; ++d0) {
            const v4u w = *(const v4u*)(qp + 16 * d0 + 8 * hi);
            float f[8] = {blo(w.x), bhi(w.x), blo(w.y), bhi(w.y), blo(w.z), bhi(w.z), blo(w.w), bhi(w.w)};
            if (d0 >= 4) {
                const float pos = isctx ? 0.f : ((d0 == 4) ? (float)(nq >> 6) : (float)(nq & 63));
#pragma unroll
                for (int j = 0; j < 8; ++j) { const float inv = __builtin_amdgcn_exp2f(-(float)j * (L2_THETA / 8.f)); const float ang = pos * inv, cs = __cosf(ang), sn = __sinf(ang);
                    const float pr = __shfl_xor(f[j], 32); f[j] = hi ? (f[j] * cs + pr * sn) : (f[j] * cs - pr * sn); }
            }
            v4u o; o.x = pk2(f[0] * qs, f[1] * qs); o.y = pk2(f[2] * qs, f[3] * qs); o.z = pk2(f[4] * qs, f[5] * qs); o.w = pk2(f[6] * qs, f[7] * qs);
            qr[d0] = __builtin_bit_cast(bf16x8, o);
        }
    } else {
        const bf16* qp = R + qtok * RW + (MIX == 1 ? 416 : 1184) + h * 64;
#pragma unroll
        for (int d0 = 0; d0 < ND; ++d0) qr[d0] = *(const bf16x8*)(qp + 16 * d0 + 8 * hi);
    }
    const bf16 *k0p, *k1p, *vp; int k0s, vs;
    if (MIX == 0) { k0p = QKVA + tokb * QW + 768 + h * 128; k0s = QW; k1p = R + tokb * RW + 384; vp = k0p + 64; vs = QW; }
    else { const int hk = h >> 2; k0p = R + tokb * RW + (MIX == 1 ? 928 : 1696) + hk * 64; k0s = RW; k1p = k0p; vp = R + tokb * RW + (MIX == 1 ? 1056 : 1824) + hk * 64; vs = RW; }
    int nt, wlo = 0;
    if (isctx) nt = 4;
    else if (MIX == 2) { const int n0 = 256 * qb; wlo = (n0 - 128 > 0 ? n0 - 128 : 0) >> 6; const int whi = (n0 + 384 < SEQ ? n0 + 384 : SEQ) >> 6; nt = 4 + (whi - wlo); }
    else nt = TPB / 64;
#define TILE_P0(ti) ((MIX == 2 && !isctx && (ti) >= 4) ? CTX + 64 * (wlo + (ti) - 4) : 64 * (ti))
    const int kr0 = tid / KCH, kc0 = tid - kr0 * KCH; const int kr1 = (tid + 512) / KCH, kc1 = (tid + 512) - kr1 * KCH; const bool k2 = (MIX == 0) && (tid < 256);
    const int vr = tid >> 3, vc = tid & 7;
    v4u kreg0, kreg1 = (v4u){0u, 0u, 0u, 0u}, vreg;
#define LOAD_TILE(ti) do { const int pk_ = TILE_P0(ti); \
        kreg0 = (MIX == 0 && kc0 >= 8) ? *(const v4u*)(k1p + (size_t)(pk_ + kr0) * RW + 8 * (kc0 - 8)) : *(const v4u*)(k0p + (size_t)(pk_ + kr0) * k0s + 8 * kc0); \
        if (k2) kreg1 = (kc1 >= 8) ? *(const v4u*)(k1p + (size_t)(pk_ + kr1) * RW + 8 * (kc1 - 8)) : *(const v4u*)(k0p + (size_t)(pk_ + kr1) * k0s + 8 * kc1); \
        vreg = *(const v4u*)(vp + (size_t)(pk_ + vr) * vs + 8 * vc); } while (0)
#define STORE_TILE(bufi) do { LAS unsigned char* kb_ = lds + (bufi) * KBUF; LAS unsigned char* vb_ = lds + 2 * KBUF + (bufi) * VBUF; \
        *(LAS v4u*)(kb_ + kr0 * KSTR + kc0 * 16) = kreg0; if (k2) *(LAS v4u*)(kb_ + kr1 * KSTR + kc1 * 16) = kreg1; \
        *(LAS v4u*)(vb_ + vr * VSTR + vc * 16) = vreg; } while (0)
    constexpr float THR = 8.0f; constexpr int NKA = (ND > 4) ? 3 : 4;
    float m_ref = 0.f, l_run = 0.f;
    if (MIX == 2) l_run = hi ? 0.f : __builtin_amdgcn_exp2f(sink[h] * LOG2E);
    f32x16 negm;
#pragma unroll
    for (int r = 0; r < 16; ++r) negm[r] = 0.f;
    f32x16 o[2];
#pragma unroll
    for (int r = 0; r < 16; ++r) { o[0][r] = 0.f; o[1][r] = 0.f; }
    const LAS unsigned char* kbase = lds + r32 * KSTR + hi * 16;
    const LAS unsigned char* vbase = lds + 2 * KBUF + (4 * hi + ((lane & 15) >> 2)) * VSTR + (16 * ((lane >> 4) & 1) + 4 * (lane & 3)) * 2;
#define LOAD_K(ti, K0, K1) do { const int pk_ = TILE_P0(ti); \
        K0 = (MIX == 0 && kc0 >= 8) ? *(const v4u*)(k1p + (size_t)(pk_ + kr0) * RW + 8 * (kc0 - 8)) : *(const v4u*)(k0p + (size_t)(pk_ + kr0) * k0s + 8 * kc0); \
        if (k2) K1 = (kc1 >= 8) ? *(const v4u*)(k1p + (size_t)(pk_ + kr1) * RW + 8 * (kc1 - 8)) : *(const v4u*)(k0p + (size_t)(pk_ + kr1) * k0s + 8 * kc1); } while (0)
#define LOAD_V(ti, V0) do { const int pk_ = TILE_P0(ti); V0 = *(const v4u*)(vp + (size_t)(pk_ + vr) * vs + 8 * vc); } while (0)
#define STORE_K(bufi, K0, K1) do { LAS unsigned char* kb_ = lds + (bufi) * KBUF; *(LAS v4u*)(kb_ + kr0 * KSTR + kc0 * 16) = K0; if (k2) *(LAS v4u*)(kb_ + kr1 * KSTR + kc1 * 16) = K1; } while (0)
#define STORE_V(bufi, V0) do { *(LAS v4u*)(lds + 2 * KBUF + (bufi) * VBUF + vr * VSTR + vc * 16) = V0; } while (0)
#define QK_PAIR(S0, S1, KB, d0) do { const bf16x8 kf0_ = *(const LAS bf16x8*)((KB) + (d0) * 32), kf1_ = *(const LAS bf16x8*)((KB) + 32 * KSTR + (d0) * 32); \
        S0 = __builtin_amdgcn_mfma_f32_32x32x16_bf16(kf0_, qr[d0], (d0) == 0 ? negm : S0, 0, 0, 0); S1 = __builtin_amdgcn_mfma_f32_32x32x16_bf16(kf1_, qr[d0], (d0) == 0 ? negm : S1, 0, 0, 0); } while (0)
#define MASK_TILE(S0, S1, ti) do { if (MIX == 2 && !isctx && (ti) >= 4) { const int nk0_ = 64 * (wlo + (ti) - 4) - nq; \
        _Pragma("unroll") for (int r = 0; r < 16; ++r) { const int d_ = nk0_ + crow(r, hi); if (d_ > 128 || d_ < -128) S0[r] = -INFINITY; if (d_ + 32 > 128 || d_ + 32 < -128) S1[r] = -INFINITY; } } } while (0)
#define DECIDE_MAX(S0, S1, RM) float RM; do { float a_ = __builtin_fmaxf(__builtin_fmaxf(S0[0], S0[1]), S0[2]), b_ = __builtin_fmaxf(__builtin_fmaxf(S0[3], S0[4]), S0[5]), c_ = __builtin_fmaxf(__builtin_fmaxf(S1[0], S1[1]), S1[2]), d_ = __builtin_fmaxf(__builtin_fmaxf(S1[3], S1[4]), S1[5]); \
        a_ = __builtin_fmaxf(__builtin_fmaxf(a_, S0[6]), S0[7]); b_ = __builtin_fmaxf(__builtin_fmaxf(b_, S0[8]), S0[9]); c_ = __builtin_fmaxf(__builtin_fmaxf(c_, S1[6]), S1[7]); d_ = __builtin_fmaxf(__builtin_fmaxf(d_, S1[8]), S1[9]); \
        a_ = __builtin_fmaxf(__builtin_fmaxf(a_, S0[10]), S0[11]); b_ = __builtin_fmaxf(__builtin_fmaxf(b_, S0[12]), S0[13]); c_ = __builtin_fmaxf(__builtin_fmaxf(c_, S1[10]), S1[11]); d_ = __builtin_fmaxf(__builtin_fmaxf(d_, S1[12]), S1[13]); \
        a_ = __builtin_fmaxf(__builtin_fmaxf(a_, S0[14]), S0[15]); c_ = __builtin_fmaxf(__builtin_fmaxf(c_, S1[14]), S1[15]); a_ = __builtin_fmaxf(a_, c_); b_ = __builtin_fmaxf(b_, d_); \
        float rm_ = __builtin_fmaxf(a_, b_); { const auto rr_ = __builtin_amdgcn_permlane32_swap(__builtin_bit_cast(unsigned, rm_), __builtin_bit_cast(unsigned, rm_), false, false); rm_ = __builtin_fmaxf(__builtin_bit_cast(float, (unsigned)rr_[0]), __builtin_bit_cast(float, (unsigned)rr_[1])); } RM = rm_; } while (0)
#define DECIDE_APPLY(S0, S1, RM) do { const float rm_ = RM; \
        if (__builtin_expect(__any(rm_ > THR), 0)) { const float dl_ = __builtin_fmaxf(rm_, 0.f); m_ref += dl_; \
            _Pragma("unroll") for (int r = 0; r < 16; ++r) { S0[r] -= dl_; S1[r] -= dl_; negm[r] = -m_ref; } \
            const float f_ = __builtin_amdgcn_exp2f(-dl_); l_run *= f_; \
            _Pragma("unroll") for (int r = 0; r < 16; ++r) { o[0][r] *= f_; o[1][r] *= f_; } } } while (0)
    f32x16 sA0, sA1, sB0, sB1;
    { v4u kp0_, kp1_ = (v4u){0u, 0u, 0u, 0u}; LOAD_K(0, kreg0, kreg1); LOAD_V(0, vreg); LOAD_K(1, kp0_, kp1_);
      STORE_K(0, kreg0, kreg1); STORE_V(0, vreg); STORE_K(1, kp0_, kp1_); }
    __syncthreads();
#pragma unroll
    for (int d0 = 0; d0 < ND; ++d0) QK_PAIR(sA0, sA1, kbase, d0);
    MASK_TILE(sA0, sA1, 0);
    { DECIDE_MAX(sA0, sA1, rm0_); DECIDE_APPLY(sA0, sA1, rm0_); }
    __syncthreads();
#define QK_MM(S0, S1, d0) do { S0 = __builtin_amdgcn_mfma_f32_32x32x16_bf16(kfr[d0][0], qr[d0], (d0) == 0 ? negm : S0, 0, 0, 0); S1 = __builtin_amdgcn_mfma_f32_32x32x16_bf16(kfr[d0][1], qr[d0], (d0) == 0 ? negm : S1, 0, 0, 0); } while (0)
#define STEP(C0, C1, N0, N1, t, LK0, LK1, LV, SK0, SK1, SV) do { \
        if ((t) + 2 < nt) LOAD_K((t) + 2, LK0, LK1); if ((t) + 1 < nt) LOAD_V((t) + 1, LV); \
        const LAS unsigned char* kb_n = kbase + (((t) + 1) & 1) * KBUF; const LAS unsigned char* vb_c = vbase + ((t) & 1) * VBUF; \
        float sum_ = 0.f, sum1_ = 0.f, sum2_ = 0.f, sum3_ = 0.f; bf16x8 pf[4]; v4u w_; bf16x8 kfr[ND][2]; \
        _Pragma("unroll") for (int d0 = 0; d0 < NKA; ++d0) { kfr[d0][0] = *(const LAS bf16x8*)(kb_n + d0 * 32); kfr[d0][1] = *(const LAS bf16x8*)(kb_n + 32 * KSTR + d0 * 32); } \
        _Pragma("unroll") for (int r = 0; r < 8; ++r) C0[r] = __builtin_amdgcn_exp2f(C0[r]); \
        sum_ += (C0[0] + C0[1]) + (C0[2] + C0[3]); sum1_ += (C0[4] + C0[5]) + (C0[6] + C0[7]); \
        QK_MM(N0, N1, 0); \
        _Pragma("unroll") for (int r = 8; r < 16; ++r) C0[r] = __builtin_amdgcn_exp2f(C0[r]); \
        sum2_ += (C0[8] + C0[9]) + (C0[10] + C0[11]); sum3_ += (C0[12] + C0[13]) + (C0[14] + C0[15]); \
        QK_MM(N0, N1, 1); \
        if (ND > NKA) { _Pragma("unroll") for (int d0 = NKA; d0 < ND; ++d0) { kfr[d0][0] = *(const LAS bf16x8*)(kb_n + d0 * 32); kfr[d0][1] = *(const LAS bf16x8*)(kb_n + 32 * KSTR + d0 * 32); } } \
        _Pragma("unroll") for (int r = 0; r < 8; ++r) C1[r] = __builtin_amdgcn_exp2f(C1[r]); \
        sum_ += (C1[0] + C1[1]) + (C1[2] + C1[3]); sum1_ += (C1[4] + C1[5]) + (C1[6] + C1[7]); \
        QK_MM(N0, N1, 2); \
        _Pragma("unroll") for (int r = 8; r < 16; ++r) C1[r] = __builtin_amdgcn_exp2f(C1[r]); \
        sum2_ += (C1[8] + C1[9]) + (C1[10] + C1[11]); sum3_ += (C1[12] + C1[13]) + (C1[14] + C1[15]); \
        QK_MM(N0, N1, 3); \
        if (ND > 4) { QK_MM(N0, N1, (ND > 4 ? 4 : 0)); QK_MM(N0, N1, (ND > 4 ? 5 : 0)); } \
        s16x4 vlo_[4], vhi_[4], vlo2_[4], vhi2_[4]; \
        _Pragma("unroll") for (int s = 0; s < 2; ++s) _Pragma("unroll") for (int d0 = 0; d0 < 2; ++d0) { vlo_[2 * s + d0] = vtr(vb_c + (16 * s) * VSTR + d0 * 64); vhi_[2 * s + d0] = vtr(vb_c + (16 * s + 8) * VSTR + d0 * 64); } \
        w_.x = cvtpk(C0[0], C0[1]); w_.y = cvtpk(C0[2], C0[3]); w_.z = cvtpk(C0[4], C0[5]); w_.w = cvtpk(C0[6], C0[7]); pf[0] = __builtin_bit_cast(bf16x8, w_); \
        w_.x = cvtpk(C0[8], C0[9]); w_.y = cvtpk(C0[10], C0[11]); w_.z = cvtpk(C0[12], C0[13]); w_.w = cvtpk(C0[14], C0[15]); pf[1] = __builtin_bit_cast(bf16x8, w_); \
        w_.x = cvtpk(C1[0], C1[1]); w_.y = cvtpk(C1[2], C1[3]); w_.z = cvtpk(C1[4], C1[5]); w_.w = cvtpk(C1[6], C1[7]); pf[2] = __builtin_bit_cast(bf16x8, w_); \
        w_.x = cvtpk(C1[8], C1[9]); w_.y = cvtpk(C1[10], C1[11]); w_.z = cvtpk(C1[12], C1[13]); w_.w = cvtpk(C1[14], C1[15]); pf[3] = __builtin_bit_cast(bf16x8, w_); \
        l_run += (sum_ + sum1_) + (sum2_ + sum3_); \
        MASK_TILE(N0, N1, (t) + 1); DECIDE_MAX(N0, N1, rmn_); \
        _Pragma("unroll") for (int s = 2; s < 4; ++s) _Pragma("unroll") for (int d0 = 0; d0 < 2; ++d0) { vlo2_[2 * (s - 2) + d0] = vtr(vb_c + (16 * s) * VSTR + d0 * 64); vhi2_[2 * (s - 2) + d0] = vtr(vb_c + (16 * s + 8) * VSTR + d0 * 64); } \
        _Pragma("unroll") for (int s = 0; s < 2; ++s) _Pragma("unroll") for (int d0 = 0; d0 < 2; ++d0) { \
            const s16x4 lo_ = vlo_[2 * s + d0], hh_ = vhi_[2 * s + d0]; \
            const bf16x8 vf_ = (bf16x8){lo_[0], lo_[1], lo_[2], lo_[3], hh_[0], hh_[1], hh_[2], hh_[3]}; \
            o[d0] = __builtin_amdgcn_mfma_f32_32x32x16_bf16(vf_, pf[s], o[d0], 0, 0, 0); } \
        _Pragma("unroll") for (int s = 2; s < 4; ++s) _Pragma("unroll") for (int d0 = 0; d0 < 2; ++d0) { \
            const s16x4 lo_ = vlo2_[2 * (s - 2) + d0], hh_ = vhi2_[2 * (s - 2) + d0]; \
            const bf16x8 vf_ = (bf16x8){lo_[0], lo_[1], lo_[2], lo_[3], hh_[0], hh_[1], hh_[2], hh_[3]}; \
            o[d0] = __builtin_amdgcn_mfma_f32_32x32x16_bf16(vf_, pf[s], o[d0], 0, 0, 0); } \
        if ((t) + 1 < nt) { DECIDE_APPLY(N0, N1, rmn_); } \
        if ((t) + 2 < nt) STORE_K((t) & 1, SK0, SK1); if ((t) + 1 < nt) STORE_V(((t) + 1) & 1, SV); \
        __syncthreads(); } while (0)
    for (int ti = 0; ti < nt; ti += 2) {
        STEP(sA0, sA1, sB0, sB1, ti, kreg0, kreg1, vreg, kreg0, kreg1, vreg);
        STEP(sB0, sB1, sA0, sA1, ti + 1, kreg0, kreg1, vreg, kreg0, kreg1, vreg);
    }
#undef STEP
#undef QK_MM
#undef DECIDE_MAX
#undef DECIDE_APPLY
#undef MASK_TILE
#undef QK_PAIR
#undef LOAD_K
#undef LOAD_V
#undef STORE_K
#undef STORE_V
#undef LOAD_TILE
#undef STORE_TILE
#undef TILE_P0
    const float lt = l_run + __shfl_xor(l_run, 32); const float il = 1.0f / lt;
    LAS unsigned char* ost = lds + 65536 + wid * 4608;
#pragma unroll
    for (int d0 = 0; d0 < 2; ++d0)
#pragma unroll
        for (int g = 0; g < 4; ++g) { v2u w; w.x = cvtpk(o[d0][4 * g] * il, o[d0][4 * g + 1] * il); w.y = cvtpk(o[d0][4 * g + 2] * il, o[d0][4 * g + 3] * il);
            *(LAS v2u*)(ost + r32 * 144 + (32 * d0 + 8 * g + 4 * hi) * 2) = w; }
    asm volatile("s_waitcnt lgkmcnt(0)" ::: "memory");
    bf16* ob = Oall + ((size_t)MIX * T + (qtok - r32)) * 512 + h * 64;
#pragma unroll
    for (int it = 0; it < 4; ++it) { const int row = (lane >> 3) + 8 * it, ch = lane & 7;
        const v4u w = *(const LAS v4u*)(ost + row * 144 + ch * 16);
        *(v4u*)(ob + (size_t)row * 512 + ch * 8) = w; }
}
__device__ __forceinline__ void attn_phase(const Args& a, int l, LAS unsigned char* lds, const bf16* R, const bf16* QKVA, bf16* Oall, int G) {
    const int nlat = 3 * 1024, ntot = nlat + ((l == 0) ? 192 : 0);
    const float* sink = a.sink + l * 8;
    const int cperm = (G == 256) ? (((((int)blockIdx.x & 7) * 2 + ((int)blockIdx.x >> 7)) << 4) + (((int)blockIdx.x >> 3) & 15)) : (int)blockIdx.x;
    for (int u = cperm; u < ntot; u += G) {
        int mix, b, h, qb;
        if (u < nlat) { mix = u >> 10; const int v = u & 1023; qb = v & 15; h = (v >> 4) & 7; b = v >> 7; }
        else { const int w = u - nlat; mix = w >> 6; const int v = w & 63; h = v & 7; b = v >> 3; qb = -1; }
        if (mix == 0) attn_unit<0>(lds, R, QKVA, Oall, sink, b, h, qb);
        else if (mix == 1) attn_unit<1>(lds, R, QKVA, Oall, sink, b, h, qb);
        else attn_unit<2>(lds, R, QKVA, Oall, sink, b, h, qb);
    }
}


constexpr int NPH = 30;
#ifndef PHM
#define PHM 0xFFFFF
#endif
__global__ void __launch_bounds__(NWAVES * 64, 2) mega_fwd(Args a) {
    extern __shared__ __attribute__((aligned(16))) unsigned char lds_raw[];
    LAS unsigned char* lds = (LAS unsigned char*)lds_raw;
    cg::grid_group grid = cg::this_grid();
    if (a.ph_lo < 0) grid.sync();
    if (threadIdx.x < 4) ((LAS unsigned*)(lds + 131072))[threadIdx.x] = 0u;
    __syncthreads();
    XcdBarrier xbar = xcd_barrier_post((unsigned*)(a.ws + WS_BAR), (volatile LAS unsigned*)(lds + 131072));
    const int G = gridDim.x;
    unsigned char* ws = a.ws;
    float* MOD = (float*)(ws + WS_MOD); float* XCTX = (float*)(ws + WS_XCTX);
    unsigned char* wb = ws + WS_W; unsigned char* dyn = ws + WS_DYN;
    const bf16* WIN = (const bf16*)(wb + W_IN); const bf16* WG = (const bf16*)(wb + W_G); const bf16* WQKV = (const bf16*)(wb + W_QKV); const bf16* WBR = (const bf16*)(wb + W_BR);
    const bf16* WOUT = (const bf16*)(wb + W_OUT); const bf16* WUP = (const bf16*)(wb + W_UP); const bf16* WDN = (const bf16*)(wb + W_DN);
    bf16* H = (bf16*)(dyn + D_H); bf16* R = (bf16*)(dyn + D_R); bf16* QKVA = (bf16*)(dyn + D_QKVA); bf16* O = (bf16*)(dyn + D_O);
    bf16* AQKV = O; bf16* Gt = R; bf16* Y = H; bf16* H2 = H; bf16* U = (bf16*)(dyn + D_U); bf16* ACT = (bf16*)(dyn + D_ACT);

#define GSYNC() xcd_barrier(xbar)
#define RUN(PH) if (a.ph_lo <= (PH) && (PH) < a.ph_hi && ((void)(((PH) > a.ph_lo) ? (xcd_barrier(xbar), 0) : 0), true))
#ifdef DBG_LAYER
    if (blockIdx.x == 0 && threadIdx.x < 64) ((unsigned*)a.ws)[threadIdx.x] = 0u;
#endif
    RUN(0) { if (PHM & 4096) mod_gemv(a, lds, G); convert_weights(a, 0, lds, G); }
#ifdef DBG_LAYER
#ifndef DBG_SET
#define DBG_SET 1
#endif
#define DBGCHK(l, w) if ((l) == DBG_LAYER && a.ph_hi == NPH && (((w) < 20 && DBG_SET == 1) || ((w) >= 20 && (w) < 23 && DBG_SET == 2) || ((w) >= 23 && (w) < 30 && DBG_SET == 4) || ((w) >= 30 && DBG_SET == 3))) { GSYNC(); dbg_check(a, (l), (w)); }
#else
#define DBGCHK(l, w)
#endif
#define LAYER(l) do { \
    const float* modl = MOD + (size_t)(l) * 9 * 6144; \
    const float* xin_lat = ((l) == 0) ? a.x : a.out; const float* xin_ctx = ((l) == 0) ? a.ctx : XCTX; \
    RUN(1 + 14 * (l) + 0) { if (PHM & 1) { if ((l) == 1) convert_weights(a, 1, lds, G); modulate_rows(xin_lat, xin_ctx, a.g_norm1 + (l) * DM, modl, 0, 1, H, G); } } \
    RUN(1 + 14 * (l) + 1) { if (PHM & 2) { pg8::Gemm g{H, WIN, T, RW, DM, 0, 0}; pg8::TileSched S; S.init(NROWT, RW / 256, 1, G, (int)blockIdx.x, 0); \
        pg8::EpiStore<0> E{R, RW, nullptr, 0}; pg8::gemm_phase<pg8::EpiStore<0>, pg8::TileSched, true, true>(lds, g, S, E); } } \
    DBGCHK((l), 1) \
    DBGCHK((l), 26) \
    RUN(1 + 14 * (l) + 2) { if (PHM & 4) post_proj_rows(a, (l), R, AQKV, G); } \
    DBGCHK((l), 20) \
    RUN(1 + 14 * (l) + 3) { if (PHM & 8) { pg8::Gemm g{AQKV, WQKV, T, QW, 384, 0, 0}; pg8::TileSched S; S.init(NROWT, QW / 256, 1, G, (int)blockIdx.x, 0); \
        pg8::EpiStore<0> E{QKVA, QW, nullptr, 0}; pg8::gemm_phase<pg8::EpiStore<0>, pg8::TileSched, true, true>(lds, g, S, E); } } \
    DBGCHK((l), 2) \
    RUN(1 + 14 * (l) + 4) { if (PHM & 16) attn_phase(a, (l), lds, R, QKVA, O, G); } \
    DBGCHK((l), 3) \
    DBGCHK((l), 30) \
    RUN(1 + 14 * (l) + 5) { if (PHM & 32) { pg8::Gemm g{H, WG, T, 3072, DM, 0, 0}; pg8::TileSched S; S.init((l) ? 128 : NROWT, 12, 1, G, (int)blockIdx.x, 0, (l)); \
        pg8::EpiStore<2> E{Gt, 3072, a.b_gate + (l) * 3072, 0}; pg8::gemm_phase<pg8::EpiStore<2>, pg8::TileSched, true, true>(lds, g, S, E); } } \
    DBGCHK((l), 4) \
    DBGCHK((l), 33) \
    DBGCHK((l), 31) \
    RUN(1 + 14 * (l) + 6) { if (PHM & 64) { pg8::Gemm g{O, WBR, T, DM, 512, (size_t)T * 512 * 2, (size_t)1024 * 512 * 2}; pg8::TileSched S; S.init((l) ? 128 : NROWT, 4, 3, G, (int)blockIdx.x, 0, (l)); \
        pg8::EpiBranch E{Y, Gt}; pg8::gemm_phase<pg8::EpiBranch, pg8::TileSched, true, true>(lds, g, S, E); } } \
    DBGCHK((l), 5) \
    DBGCHK((l), 27) \
    RUN(1 + 14 * (l) + 7) { if (PHM & 128) { pg8::Gemm g{Y, WOUT, T, DM, DM, 0, 0}; pg8::TileSched S; S.init((l) ? 128 : NROWT, 4, 1, G, (int)blockIdx.x, 0, (l)); \
        pg8::EpiResid E{xin_lat, xin_ctx, a.out, XCTX, modl + 2 * 1024}; pg8::gemm_phase<pg8::EpiResid, pg8::TileSched, true, true>(lds, g, S, E); } } \
    DBGCHK((l), 6) \
    DBGCHK((l), 28) \
    RUN(1 + 14 * (l) + 8) { if (PHM & 256) modulate_rows(a.out, XCTX, a.g_norm2 + (l) * DM, modl, 3, 4, H2, G); } \
    DBGCHK((l), 25) \
    RUN(1 + 14 * (l) + 9) { if (PHM & 512) { pg8::Gemm g{H2, WUP, T, NUP, DM, 0, 0}; pg8::TileSched S; S.init(NROWT / 2, NUP / 256, 1, G, (int)blockIdx.x, 0); \
        pg8::EpiStore<0> E{U, NUP, nullptr, 0}; pg8::gemm_phase<pg8::EpiStore<0>, pg8::TileSched, true, true>(lds, g, S, E); } } \
    DBGCHK((l), 7) \
    RUN(1 + 14 * (l) + 10) { if (PHM & 1024) conv_act(a, (l), 0, U, ACT, G); } \
    DBGCHK((l), 8) \
    RUN(1 + 14 * (l) + 11) { if (PHM & 512) { pg8::Gemm g{H2, WUP, T, NUP, DM, 0, 0}; pg8::TileSched S; S.init(NROWT / 2, NUP / 256, 1, G, (int)blockIdx.x, NROWT / 2); \
        pg8::EpiStore<0> E{U, NUP, nullptr, THALF}; pg8::gemm_phase<pg8::EpiStore<0>, pg8::TileSched, true, true>(lds, g, S, E); } } \
    DBGCHK((l), 23) \
    RUN(1 + 14 * (l) + 12) { if (PHM & 1024) conv_act(a, (l), 1, U, ACT, G); } \
    DBGCHK((l), 21) \
    DBGCHK((l), 24) \
    RUN(1 + 14 * (l) + 13) { if (PHM & 2048) { pg8::Gemm g{ACT, WDN, T, DM, DFF, 0, 0}; pg8::TileSched S; S.init((l) ? 128 : NROWT, 4, 1, G, (int)blockIdx.x, 0, (l)); \
        pg8::EpiResid E{a.out, XCTX, a.out, XCTX, modl + 5 * 1024}; pg8::gemm_phase<pg8::EpiResid, pg8::TileSched, true, true>(lds, g, S, E); } } \
    DBGCHK((l), 22) \
    } while (0)
    LAYER(0);
    LAYER(1);
    RUN(NPH - 1) { final_norm(a, G); }
#ifdef DBG_LAYER
#ifndef DBG_NOREPORT
    GSYNC(); dbg_report(a);
#endif
#endif
#undef LAYER
#undef RUN
}

#ifndef MK_SINGLE
#define MK_SINGLE 1
#endif
extern "C" void kernel_launch(void* const* d_in, const int* in_sizes, int n_in, void* d_out, int out_size, void* d_ws, size_t ws_size, hipStream_t stream) {
    static int grid = 0;
    if (grid == 0) {
        if (n_in != 24 || ws_size < WS_END) { fprintf(stderr, "kernel_launch: need 24 inputs and %zu bytes of workspace (got %d, %zu)\n", (size_t)WS_END, n_in, ws_size); grid = -1; return; }
        int dev = 0, cus = 0, per_cu = 0;
        hipGetDevice(&dev); hipDeviceGetAttribute(&cus, hipDeviceAttributeMultiprocessorCount, dev);
        if (hipFuncSetAttribute((const void*)mega_fwd, hipFuncAttributeMaxDynamicSharedMemorySize, LDS_BYTES) != hipSuccess) { fprintf(stderr, "kernel_launch: hipFuncSetAttribute failed\n"); grid = -1; return; }
        if (hipOccupancyMaxActiveBlocksPerMultiprocessor(&per_cu, (const void*)mega_fwd, NWAVES * 64, LDS_BYTES) != hipSuccess || per_cu < 1) { fprintf(stderr, "kernel_launch: occupancy query says %d\n", per_cu); per_cu = 1; }
        (void)hipGetLastError();
        grid = cus * per_cu;
    }
    if (grid < 0) return;
    Args a{};
    const float** ap = (const float**)&a;
    for (int i = 0; i < 24; ++i) ap[i] = (const float*)d_in[i];
    a.out = (float*)d_out; a.ws = (unsigned char*)d_ws;
    if (hipMemsetAsync((char*)d_ws + WS_BAR, 0, XCD_BAR_WORDS * 4, stream) != hipSuccess) { fprintf(stderr, "kernel_launch: memset of barrier words failed\n"); return; }
#if MK_SINGLE
    a.ph_lo = 0; a.ph_hi = NPH;
    void* args[] = {&a};
    hipError_t e = hipLaunchCooperativeKernel((const void*)mega_fwd, dim3(grid), dim3(NWAVES * 64), args, LDS_BYTES, stream);
    if (e != hipSuccess) fprintf(stderr, "cooperative launch failed: %s (grid %d)\n", hipGetErrorString(e), grid);
#else
    for (int ph = 0; ph < NPH; ++ph) { a.ph_lo = ph; a.ph_hi = ph + 1; hipLaunchKernelGGL(mega_fwd, dim3(grid), dim3(NWAVES * 64), LDS_BYTES, stream, a); }
#endif
}
```

```cpp
#include <hip/hip_runtime.h>
#include <hip/hip_cooperative_groups.h>
#include <cstdio>
#include <cstdint>
namespace cg = cooperative_groups;
namespace pg8 {
#define PG8_LAS __attribute__((address_space(3)))
typedef unsigned short bf16_t;
typedef short bf16x8 __attribute__((ext_vector_type(8)));
typedef float f32x4 __attribute__((ext_vector_type(4)));
typedef unsigned u32x4 __attribute__((ext_vector_type(4)));
constexpr int BM = 256, BK = 64, HALF = 128, HTB = HALF * BK * 2  , STAGE_BYTES = 8 * HTB, NXCD = 8, WGM = 8;

__host__ __device__ __forceinline__ int lds_byte(int r, int c) { const int st = (r >> 4) * 2 + (c >> 5), rr = r & 15, cc = c & 31, ob = rr * 64 + cc * 2; return st * 1024 + (ob ^ (((ob >> 9) & 1) << 5)); }
__host__ __device__ __forceinline__ void stage_rc(int b, int& R, int& C) { const int st = b / 1024, sb = b % 1024, swz = sb ^ (((sb >> 9) & 1) << 5); R = (st >> 1) * 16 + swz / 64; C = (st & 1) * 32 + (swz % 64) / 2; }
__host__ __device__ __forceinline__ int perm32(int rho) { const int n = rho >> 4, i = rho & 15; return 8 * (i >> 2) + 4 * n + (i & 3); }

struct Unit { int pm, pn, z; };
struct Gemm { const bf16_t* A; const bf16_t* Bt; int M, N, K; size_t zA, zB; };
typedef float f32x2_cv __attribute__((ext_vector_type(2))); typedef __bf16 bf16x2_cv __attribute__((ext_vector_type(2)));
__device__ __forceinline__ unsigned cvt_pk_bf16(float lo, float hi) { f32x2_cv v = {lo, hi}; bf16x2_cv b = __builtin_convertvector(v, bf16x2_cv); return __builtin_bit_cast(unsigned, b); }
typedef float f32x2 __attribute__((ext_vector_type(2)));
template <class Epi, class Sched, bool ALIGN_EPI = false, bool SP2 = false>
__device__ __forceinline__ void gemm_phase(PG8_LAS unsigned char* lds, const Gemm g, const Sched& S, const Epi& E) {
    int tid_ = threadIdx.x; asm volatile("" : "+v"(tid_));
    const int tid = tid_, wid = __builtin_amdgcn_readfirstlane(tid >> 6), lane = tid & 63, wr = wid >> 2, wc = wid & 3, fr = lane & 15, fq = lane >> 4;
    const int K = g.K, nt = K / BK;
    unsigned voffA[2], voffB[2];
#pragma unroll
    for (int i = 0; i < 2; ++i) { int R, C; stage_rc(tid * 16 + i * 8192, R, C); const int Rb = Epi::PERM ? ((R & ~31) + perm32(R & 31)) : R;
        voffA[i] = (unsigned)(R * K + C) * 2u; voffB[i] = (unsigned)(Rb * K + C) * 2u; }
    const size_t kstep = (size_t)(BK * 2);
    const size_t hstep = (size_t)HALF * K * 2;
    const size_t tstep = 2 * hstep;
    const unsigned ldsw = (unsigned)wid * 1024u;
    const int aoff = lds_byte(wr * 64 + fr, fq * 8), boff = lds_byte(wc * 32 + fr, fq * 8);
#define PG8_SA(b, h) (((b) * 2 + (h)) * HTB)
#define PG8_SB(b, h) ((4 + (b) * 2 + (h)) * HTB)
#define PG8_STAGE(bufoff, gbase, voff) do { _Pragma("unroll") for (int _i = 0; _i < 2; ++_i) \
        __builtin_amdgcn_global_load_lds((const unsigned*)((const char*)(gbase) + (voff)[_i]), (PG8_LAS unsigned*)(lds + (bufoff) + ldsw + _i * 8192), 16, 0, 0); } while (0)
#define PG8_LDA(dst, b, h) do { _Pragma("unroll") for (int m = 0; m < 4; ++m) _Pragma("unroll") for (int k = 0; k < 2; ++k) dst[m][k] = *(const PG8_LAS bf16x8*)(lds + PG8_SA(b, h) + aoff + m * 2048 + k * 1024); } while (0)
#define PG8_LDB(dst, b, h) do { _Pragma("unroll") for (int n = 0; n < 2; ++n) _Pragma("unroll") for (int k = 0; k < 2; ++k) dst[n][k] = *(const PG8_LAS bf16x8*)(lds + PG8_SB(b, h) + boff + n * 2048 + k * 1024); } while (0)
#define PG8_MMA(ai, bj, At, Bt) do { __builtin_amdgcn_s_setprio(1); _Pragma("unroll") for (int m = 0; m < 4; ++m) _Pragma("unroll") for (int n = 0; n < 2; ++n) _Pragma("unroll") for (int k = 0; k < 2; ++k) \
        acc[ai][bj][m][n] = __builtin_amdgcn_mfma_f32_16x16x32_bf16(Bt[n][k], At[m][k], acc[ai][bj][m][n], 0, 0, 0); __builtin_amdgcn_s_setprio(0); } while (0)
#define PG8_WAIT_V(n) asm volatile("s_waitcnt vmcnt(" #n ")" ::: "memory")
#define PG8_WAIT_L(n) asm volatile("s_waitcnt lgkmcnt(" #n ")" ::: "memory")
#define PG8_BAR __builtin_amdgcn_s_barrier()
#define PG8_SCHED __builtin_amdgcn_sched_barrier(0)
    Unit cur, nxt; int ui = 0;
    if (!S.next(0, cur)) return;
    f32x4 acc[2][2][4][2];
#pragma unroll
    for (int a = 0; a < 2; ++a)
#pragma unroll
        for (int b = 0; b < 2; ++b)
#pragma unroll
            for (int m = 0; m < 4; ++m)
#pragma unroll
                for (int n = 0; n < 2; ++n) acc[a][b][m][n] = (f32x4){0.f, 0.f, 0.f, 0.f};
    bf16x8 At[4][2], B0[2][2], B1[2][2];
    const char* cA = (const char*)g.A + (size_t)cur.z * g.zA + (size_t)cur.pm * tstep; const char* cB = (const char*)g.Bt + (size_t)cur.z * g.zB + (size_t)cur.pn * tstep;
    S.a_ready(cur);
    if constexpr (SP2) {
        PG8_STAGE(PG8_SB(0, 0), cB, voffB); PG8_STAGE(PG8_SB(0, 1), cB + hstep, voffB); PG8_STAGE(PG8_SA(0, 0), cA, voffA); PG8_STAGE(PG8_SA(0, 1), cA + hstep, voffA);
        if (wr == 1) PG8_BAR;
        PG8_WAIT_V(2); PG8_BAR;
        PG8_STAGE(PG8_SB(1, 0), cB + kstep, voffB); PG8_STAGE(PG8_SA(1, 0), cA + kstep, voffA); PG8_STAGE(PG8_SB(1, 1), cB + hstep + kstep, voffB);
        PG8_WAIT_V(6); PG8_BAR;
    } else {
        PG8_STAGE(PG8_SB(0, 0), cB, voffB); PG8_STAGE(PG8_SA(0, 0), cA, voffA); PG8_STAGE(PG8_SB(0, 1), cB + hstep, voffB); PG8_STAGE(PG8_SA(0, 1), cA + hstep, voffA);
        if (wr == 1) PG8_BAR;
        PG8_WAIT_V(4); PG8_BAR;
        PG8_STAGE(PG8_SB(1, 0), cB + kstep, voffB); PG8_STAGE(PG8_SA(1, 0), cA + kstep, voffA); PG8_STAGE(PG8_SB(1, 1), cB + hstep + kstep, voffB);
        PG8_WAIT_V(6); PG8_BAR;
    }
    for (;;) {
        const bool has_next = S.next(ui + 1, nxt);
        const char* nA = has_next ? (const char*)g.A + (size_t)nxt.z * g.zA + (size_t)nxt.pm * tstep : cA; const char* nB = has_next ? (const char*)g.Bt + (size_t)nxt.z * g.zB + (size_t)nxt.pn * tstep : cB;
        for (int t = 0; t < nt; t += 2) {
            const bool last = (t == nt - 2);
            const char* a1 = cA + (size_t)(t + 1) * kstep;
            const char* a2 = last ? nA : cA + (size_t)(t + 2) * kstep; const char* b2 = last ? nB : cB + (size_t)(t + 2) * kstep;
            const char* a3 = a2 + kstep; const char* b3 = b2 + kstep;
            if (last && has_next) S.a_ready(nxt);
            if constexpr (SP2) {
            PG8_LDB(B0, 0, 0); PG8_LDB(B1, 0, 1); PG8_SCHED; PG8_LDA(At, 0, 0); PG8_STAGE(PG8_SA(1, 1), a1 + hstep, voffA);
            PG8_WAIT_V(8); PG8_WAIT_L(0); PG8_BAR; PG8_MMA(0, 0, At, B0); PG8_MMA(0, 1, At, B1); PG8_BAR; PG8_SCHED;
            PG8_LDA(At, 0, 1); PG8_STAGE(PG8_SB(0, 0), b2, voffB); PG8_STAGE(PG8_SB(0, 1), b2 + hstep, voffB); PG8_STAGE(PG8_SA(0, 0), a2, voffA);
            PG8_WAIT_V(8); PG8_WAIT_L(0); PG8_BAR; PG8_MMA(1, 0, At, B0); PG8_MMA(1, 1, At, B1); PG8_BAR; PG8_SCHED;
            PG8_LDB(B0, 1, 0); PG8_LDB(B1, 1, 1); PG8_SCHED; PG8_LDA(At, 1, 0); PG8_STAGE(PG8_SA(0, 1), a2 + hstep, voffA);
            PG8_WAIT_V(8); PG8_WAIT_L(0); PG8_BAR; PG8_MMA(0, 0, At, B0); PG8_MMA(0, 1, At, B1); PG8_BAR; PG8_SCHED;
            PG8_LDA(At, 1, 1); PG8_STAGE(PG8_SB(1, 0), b3, voffB); PG8_STAGE(PG8_SB(1, 1), b3 + hstep, voffB); PG8_STAGE(PG8_SA(1, 0), a3, voffA);
            PG8_WAIT_V(8); PG8_WAIT_L(0); PG8_BAR; PG8_MMA(1, 0, At, B0); PG8_MMA(1, 1, At, B1); PG8_BAR; PG8_SCHED;
            } else {
            PG8_LDB(B0, 0, 0); PG8_SCHED; PG8_LDA(At, 0, 0); PG8_STAGE(PG8_SA(1, 1), a1 + hstep, voffA);
            PG8_WAIT_L(8); PG8_BAR; PG8_WAIT_L(0); PG8_MMA(0, 0, At, B0); PG8_BAR; PG8_SCHED;
            PG8_LDB(B1, 0, 1); PG8_STAGE(PG8_SB(0, 0), b2, voffB);
            PG8_BAR; PG8_WAIT_L(0); PG8_MMA(0, 1, At, B1); PG8_BAR;
            PG8_LDA(At, 0, 1); PG8_STAGE(PG8_SA(0, 0), a2, voffA);
            PG8_BAR; PG8_WAIT_L(0); PG8_MMA(1, 0, At, B0); PG8_BAR; PG8_SCHED;
            PG8_STAGE(PG8_SB(0, 1), b2 + hstep, voffB);
            PG8_WAIT_V(6); PG8_BAR; PG8_MMA(1, 1, At, B1); PG8_BAR;
            PG8_LDB(B0, 1, 0); PG8_SCHED; PG8_LDA(At, 1, 0); PG8_STAGE(PG8_SA(0, 1), a2 + hstep, voffA);
            PG8_WAIT_L(8); PG8_BAR; PG8_WAIT_L(0); PG8_MMA(0, 0, At, B0); PG8_BAR; PG8_SCHED;
            PG8_LDB(B1, 1, 1); PG8_STAGE(PG8_SB(1, 0), b3, voffB);
            PG8_BAR; PG8_WAIT_L(0); PG8_MMA(0, 1, At, B1); PG8_BAR;
            PG8_LDA(At, 1, 1); PG8_STAGE(PG8_SA(1, 0), a3, voffA);
            PG8_BAR; PG8_WAIT_L(0); PG8_MMA(1, 0, At, B0); PG8_BAR; PG8_SCHED;
            PG8_STAGE(PG8_SB(1, 1), b3 + hstep, voffB);
            PG8_WAIT_V(6); PG8_BAR; PG8_MMA(1, 1, At, B1); PG8_BAR;
            }
        }
        if constexpr (ALIGN_EPI) { if (wr == 0) PG8_BAR; }
        if constexpr (!Epi::AFTER_DRAIN) { E(acc, cur, wr, wc, fr, fq); S.done(cur); }
        if (!has_next) break;
#pragma unroll
        for (int a = 0; a < 2; ++a)
#pragma unroll
            for (int b = 0; b < 2; ++b)
#pragma unroll
                for (int m = 0; m < 4; ++m)
#pragma unroll
                    for (int n = 0; n < 2; ++n) acc[a][b][m][n] = (f32x4){0.f, 0.f, 0.f, 0.f};
        cur = nxt; cA = nA; cB = nB; ++ui;
        if constexpr (ALIGN_EPI) { if (wr == 1) PG8_BAR; }
    }
    PG8_WAIT_V(0);
    if constexpr (!ALIGN_EPI) { if (wr == 0) PG8_BAR; }
    PG8_BAR;
    if constexpr (Epi::AFTER_DRAIN) { E.fused(acc, cur, wr, wc, fr, fq, lds, wid, lane); S.done(cur); }
#undef PG8_SA
#undef PG8_SB
#undef PG8_STAGE
#undef PG8_LDA
#undef PG8_LDB
#undef PG8_MMA
#undef PG8_WAIT_V
#undef PG8_WAIT_L
#undef PG8_BAR
#undef PG8_SCHED
}

struct TileSched {
    int nM, nN, nZ, ntiles, G, c, pm0, latonly;
    __device__ void init(int nM_, int nN_, int nZ_, int G_, int c_, int pm0_, int lat_ = 0) { nM = nM_; nN = nN_; nZ = nZ_; ntiles = nM_ * nN_; G = G_; c = c_; pm0 = pm0_; latonly = lat_; }
    __device__ bool next(int i, Unit& u) const {
        const int ti = i / nZ, z = i - ti * nZ; const long L = (long)ti * G + c; if (L >= ntiles) return false;
        int wgid = (int)L; { const int q = ntiles / NXCD, r = ntiles % NXCD, xcd = wgid % NXCD, off = wgid / NXCD; wgid = (xcd < r ? xcd * (q + 1) : r * (q + 1) + (xcd - r) * q) + off; }
        const int nig = WGM * nN, gid = wgid / nig, fm = gid * WGM, gsz = (nM - fm) < WGM ? (nM - fm) : WGM;
        int pm = pm0 + fm + ((wgid % nig) % gsz); if (latonly) pm = 17 * (pm >> 4) + 1 + (pm & 15);
        u.pm = pm; u.pn = (wgid % nig) / gsz; u.z = z; return true;
    }
    __device__ __forceinline__ void a_ready(const Unit&) const {}
    __device__ __forceinline__ void done(const Unit&) const {}
};
__device__ __forceinline__ float bf_lo(unsigned w) { return __builtin_bit_cast(float, w << 16); }
__device__ __forceinline__ float bf_hi(unsigned w) { return __builtin_bit_cast(float, w & 0xffff0000u); }
typedef unsigned u32x2 __attribute__((ext_vector_type(2)));
__device__ __forceinline__ float sigmoidf_(float x) { return __builtin_amdgcn_rcpf(1.0f + __builtin_amdgcn_exp2f(-1.4426950408889634f * x)); }

template <int ACT  > struct EpiStore {
    static constexpr bool PERM = true, AFTER_DRAIN = false;
    bf16_t* O; int ldc; const float* bias; int row_off;
    __device__ __forceinline__ void operator()(const f32x4 (&acc)[2][2][4][2], const Unit& u, int wr, int wc, int fr, int fq) const {
        const int row0 = u.pm * BM - row_off + wr * 64 + fr; const int col0 = u.pn * BM + wc * 32 + 8 * fq;
        f32x4 bv[2][2];
#pragma unroll
        for (int bj = 0; bj < 2; ++bj)
#pragma unroll
            for (int n = 0; n < 2; ++n) bv[bj][n] = (ACT == 2) ? *(const f32x4*)(bias + col0 + bj * HALF + 4 * n) : (f32x4){0.f, 0.f, 0.f, 0.f};
#pragma unroll
        for (int ai = 0; ai < 2; ++ai)
#pragma unroll
            for (int m = 0; m < 4; ++m) { bf16_t* rowp = O + (size_t)(row0 + ai * HALF + m * 16) * ldc + col0;
#pragma unroll
                for (int bj = 0; bj < 2; ++bj) { f32x4 v0 = acc[ai][bj][m][0] + bv[bj][0], v1 = acc[ai][bj][m][1] + bv[bj][1];
                    if (ACT == 2) {
                        unsigned q0[4], q1[4];
#pragma unroll
                        for (int e = 0; e < 4; ++e) { q0[e] = (unsigned)(sigmoidf_(v0[e]) * 255.f + 0.5f); q1[e] = (unsigned)(sigmoidf_(v1[e]) * 255.f + 0.5f); }
                        u32x2 w; w.x = q0[0] | (q0[1] << 8) | (q0[2] << 16) | (q0[3] << 24); w.y = q1[0] | (q1[1] << 8) | (q1[2] << 16) | (q1[3] << 24);
                        *(u32x2*)((unsigned char*)O + (size_t)(row0 + ai * HALF + m * 16) * ldc + col0 + bj * HALF) = w;
                    } else {
                    u32x4 w; w.x = cvt_pk_bf16(v0[0], v0[1]); w.y = cvt_pk_bf16(v0[2], v0[3]); w.z = cvt_pk_bf16(v1[0], v1[1]); w.w = cvt_pk_bf16(v1[2], v1[3]);
                    *(u32x4*)(rowp + bj * HALF) = w; } } }
    }
};
struct EpiBranch {
    static constexpr bool PERM = true, AFTER_DRAIN = false;
    bf16_t* Y; const bf16_t* G;
    __device__ __forceinline__ void operator()(const f32x4 (&acc)[2][2][4][2], const Unit& u, int wr, int wc, int fr, int fq) const {
        const int row0 = u.pm * BM + wr * 64 + fr; const int col0 = u.pn * BM + wc * 32 + 8 * fq; const int z = u.z;
#pragma unroll
        for (int ai = 0; ai < 2; ++ai)
#pragma unroll
            for (int m = 0; m < 4; ++m) { const size_t row = (size_t)(row0 + ai * HALF + m * 16);
#pragma unroll
                for (int bj = 0; bj < 2; ++bj) { const int col = col0 + bj * HALF;
                    const u32x2 gq = *(const u32x2*)((const unsigned char*)G + row * 3072 + z * 1024 + col); const float gs = 1.0f / 255.0f;
                    u32x4 yo = (u32x4){0u, 0u, 0u, 0u}; if (z) yo = *(const u32x4*)(Y + row * 1024 + col);
                    const f32x4 a0 = acc[ai][bj][m][0], a1 = acc[ai][bj][m][1];
                    u32x4 w;
                    w.x = cvt_pk_bf16(bf_lo(yo.x) + (float)(gq.x & 255u) * gs * a0[0], bf_hi(yo.x) + (float)((gq.x >> 8) & 255u) * gs * a0[1]);
                    w.y = cvt_pk_bf16(bf_lo(yo.y) + (float)((gq.x >> 16) & 255u) * gs * a0[2], bf_hi(yo.y) + (float)(gq.x >> 24) * gs * a0[3]);
                    w.z = cvt_pk_bf16(bf_lo(yo.z) + (float)(gq.y & 255u) * gs * a1[0], bf_hi(yo.z) + (float)((gq.y >> 8) & 255u) * gs * a1[1]);
                    w.w = cvt_pk_bf16(bf_lo(yo.w) + (float)((gq.y >> 16) & 255u) * gs * a1[2], bf_hi(yo.w) + (float)(gq.y >> 24) * gs * a1[3]);
                    *(u32x4*)(Y + row * 1024 + col) = w; }
                if (m & 1) asm volatile("" ::: "memory"); }
    }
};
struct EpiResid {
    static constexpr bool PERM = true, AFTER_DRAIN = false;
    const float* xin_lat; const float* xin_ctx; float* xo_lat; float* xo_ctx; const float* gate;
    __device__ __forceinline__ void operator()(const f32x4 (&acc)[2][2][4][2], const Unit& u, int wr, int wc, int fr, int fq) const {
        const int b = u.pm / 17, j = u.pm - b * 17;
        const float* xi = (j == 0) ? xin_ctx + (size_t)b * 256 * 1024 : xin_lat + ((size_t)b * 4096 + (size_t)(j - 1) * 256) * 1024;
        float* xo = (j == 0) ? xo_ctx + (size_t)b * 256 * 1024 : xo_lat + ((size_t)b * 4096 + (size_t)(j - 1) * 256) * 1024;
        const float* gv = gate + (size_t)((j == 0) ? 8 : b) * 6144;
        const int lr0 = wr * 64 + fr; const int col0 = u.pn * BM + wc * 32 + 8 * fq;
        f32x4 g[2][2];
#pragma unroll
        for (int bj = 0; bj < 2; ++bj)
#pragma unroll
            for (int n = 0; n < 2; ++n) g[bj][n] = *(const f32x4*)(gv + col0 + bj * HALF + 4 * n);
#pragma unroll
        for (int ai = 0; ai < 2; ++ai)
#pragma unroll
            for (int m = 0; m < 4; ++m) { const size_t off = (size_t)(lr0 + ai * HALF + m * 16) * 1024 + col0;
#pragma unroll
                for (int bj = 0; bj < 2; ++bj) {
                    const f32x4 x0 = *(const f32x4*)(xi + off + bj * HALF), x1 = *(const f32x4*)(xi + off + bj * HALF + 4);
                    *(f32x4*)(xo + off + bj * HALF) = x0 + g[bj][0] * acc[ai][bj][m][0];
                    *(f32x4*)(xo + off + bj * HALF + 4) = x1 + g[bj][1] * acc[ai][bj][m][1]; }
                if (m & 1) asm volatile("" ::: "memory"); }
    }
};
}

#define LAS __attribute__((address_space(3)))
typedef unsigned short bf16;
typedef unsigned v4u __attribute__((ext_vector_type(4)));
typedef unsigned v2u __attribute__((ext_vector_type(2)));
typedef float f32x4 __attribute__((ext_vector_type(4)));
typedef float f32x16 __attribute__((ext_vector_type(16)));
typedef short bf16x8 __attribute__((ext_vector_type(8)));
typedef short s16x4 __attribute__((ext_vector_type(4)));

constexpr int DM = 1024, NB = 8, SEQ = 4096, CTX = 256, TPB = SEQ + CTX, T = NB * TPB;
constexpr int NROWT = T / 256;
constexpr int DFF = 2816, NUP = 2 * DFF, INC = 5024, RW = 2048, QW = 1792, THALF = T / 2;
constexpr float EPS = 1e-6f, LOG2E = 1.4426950408889634f, L2_THETA = 13.287712379549449f;
constexpr int NWAVES = 8, LDS_BYTES = 147456;

constexpr size_t WS_MOD = 4096, WS_XCTX = 0x80000, WS_W = 0x880000;
constexpr size_t W_IN = 0, W_G = W_IN + (size_t)2048 * 1024 * 2, W_QKV = W_G + (size_t)3072 * 1024 * 2, W_BR = W_QKV + (size_t)1792 * 384 * 2,
                 W_OUT = W_BR + (size_t)3 * 1024 * 512 * 2, W_UP = W_OUT + (size_t)1024 * 1024 * 2, W_DN = W_UP + (size_t)NUP * 1024 * 2, W_END = W_DN + (size_t)1024 * DFF * 2;
constexpr size_t WS_DYN = WS_W + W_END;
constexpr size_t D_H = 0, D_R = D_H + (size_t)T * 1024 * 2, D_QKVA = D_R + (size_t)T * RW * 2, D_O = D_QKVA + (size_t)T * QW * 2, D_ATT_END = D_O + (size_t)3 * T * 512 * 2;
constexpr size_t D_U = D_R, D_ACT = D_U + (size_t)THALF * NUP * 2, D_FFN_END = D_ACT + (size_t)T * DFF * 2;
constexpr size_t WS_BAR = WS_DYN + (D_FFN_END > D_ATT_END ? D_FFN_END : D_ATT_END);
constexpr size_t WS_END = WS_BAR + 16384;
static_assert(WS_DYN % 256 == 0 && (size_t)T * 3072 * 2 <= D_O - D_R, "ws map");

struct Args {
    const float *x, *c, *ctx, *c_ctx, *w_mod, *b_mod, *g_norm1, *w_in, *b_gate, *g_q_a, *w_q_b, *g_kv_a, *w_kv_b, *g_qn, *g_kn, *sink, *w_branch, *w_out, *g_norm2, *w_up, *w_conv, *b_conv, *w_down, *g_final;
    float* out; unsigned char* ws; int ph_lo, ph_hi;
};

__device__ __forceinline__ unsigned f2bf(float f) { unsigned u = __builtin_bit_cast(unsigned, f); return (u + 0x7fffu + ((u >> 16) & 1u)) >> 16; }
__device__ __forceinline__ unsigned pk2(float lo, float hi) { return f2bf(lo) | (f2bf(hi) << 16); }
__device__ __forceinline__ float blo(unsigned w) { return __builtin_bit_cast(float, w << 16); }
__device__ __forceinline__ float bhi(unsigned w) { return __builtin_bit_cast(float, w & 0xffff0000u); }
__device__ __forceinline__ float wave_sum(float v) {
#pragma unroll
    for (int o = 1; o < 64; o <<= 1) v += __shfl_xor(v, o);
    return v;
}
#define LDS_WAIT() asm volatile("s_waitcnt lgkmcnt(0)" ::: "memory")

__device__ __forceinline__ void conv_item(const float* W, int ldw, int ncol0, bf16* WT, int ldt, int drow0, int dk0, int kb, int nb, LAS float* scr, int lane) {
    const int k0 = 64 * kb, n0 = 32 * nb;
#pragma unroll 8
    for (int i = 0; i < 32; ++i) { const int kk = 2 * i + (lane >> 5); scr[kk * 33 + (lane & 31)] = W[(size_t)(k0 + kk) * ldw + ncol0 + n0 + (lane & 31)]; }
    LDS_WAIT(); asm volatile("" ::: "memory");
    const int c = lane & 7;
#pragma unroll
    for (int j = 0; j < 4; ++j) { const int n = (lane >> 3) + 8 * j; const LAS float* s = scr + (8 * c) * 33 + n;
        v4u o; o.x = pk2(s[0 * 33], s[1 * 33]); o.y = pk2(s[2 * 33], s[3 * 33]); o.z = pk2(s[4 * 33], s[5 * 33]); o.w = pk2(s[6 * 33], s[7 * 33]);
        *(v4u*)(WT + (size_t)(drow0 + n0 + n) * ldt + dk0 + k0 + 8 * c) = o; }
    LDS_WAIT(); asm volatile("" ::: "memory");
}
__device__ __forceinline__ void convert_weights(const Args& a, int l, LAS unsigned char* lds, int G) {
    const int tid = threadIdx.x, lane = tid & 63, wave = tid >> 6;
    unsigned char* wb = a.ws + WS_W;
    bf16* WIN = (bf16*)(wb + W_IN); bf16* WG = (bf16*)(wb + W_G); bf16* WQKV = (bf16*)(wb + W_QKV); bf16* WBR = (bf16*)(wb + W_BR);
    bf16* WOUT = (bf16*)(wb + W_OUT); bf16* WUP = (bf16*)(wb + W_UP); bf16* WDN = (bf16*)(wb + W_DN);
    LAS float* scr = (LAS float*)(lds + wave * 16384);
    const int gw = blockIdx.x * NWAVES + wave, NGW = G * NWAVES;
    constexpr int I1 = 16 * 61, I2 = 16 * 96, I3 = 4 * 24, I4 = 2 * 32, I5 = 8 * 32, I6 = 16 * 32, I7 = 16 * 176, I8 = 44 * 32;
    constexpr int NIT = I1 + I2 + I3 + I4 + 3 * I5 + I6 + I7 + I8;
    const float* w_in = a.w_in + (size_t)l * 1024 * INC;
    for (int it = gw; it < NIT; it += NGW) {
        int r = it;
        if (r < I1) { conv_item(w_in, INC, 0, WIN, 1024, 0, 0, r / 61, r % 61, scr, lane); continue; } r -= I1;
        if (r < I2) { conv_item(w_in, INC, 1952, WG, 1024, 0, 0, r / 96, r % 96, scr, lane); continue; } r -= I2;
        if (r < I3) { conv_item(a.w_q_b + (size_t)l * 256 * 768, 768, 0, WQKV, 384, 0, 0, r / 24, r % 24, scr, lane); continue; } r -= I3;
        if (r < I4) { conv_item(a.w_kv_b + (size_t)l * 128 * 1024, 1024, 0, WQKV, 384, 768, 256, r / 32, r % 32, scr, lane); continue; } r -= I4;
        if (r < 3 * I5) { const int i = r / I5; r -= i * I5; conv_item(a.w_branch + ((size_t)l * 3 + i) * 512 * 1024, 1024, 0, WBR + (size_t)i * 1024 * 512, 512, 0, 0, r / 32, r % 32, scr, lane); continue; } r -= 3 * I5;
        if (r < I6) { conv_item(a.w_out + (size_t)l * 1024 * 1024, 1024, 0, WOUT, 1024, 0, 0, r / 32, r % 32, scr, lane); continue; } r -= I6;
        if (r < I7) { conv_item(a.w_up + (size_t)l * 1024 * NUP, NUP, 0, WUP, 1024, 0, 0, r / 176, r % 176, scr, lane); continue; } r -= I7;
        conv_item(a.w_down + (size_t)l * DFF * 1024, 1024, 0, WDN, DFF, 0, 0, r / 32, r % 32, scr, lane);
    }
    const int gt = blockIdx.x * 512 + tid, NGT = G * 512; const v4u z4 = (v4u){0u, 0u, 0u, 0u};
    for (int i = gt; i < 12288 + 12288 + 32768; i += NGT) {
        if (i < 12288) { *(v4u*)(WIN + (size_t)1952 * 1024 + (size_t)i * 8) = z4; }
        else if (i < 24576) { const int j = i - 12288; *(v4u*)(WQKV + (size_t)(j >> 4) * 384 + 256 + (j & 15) * 8) = z4; }
        else { const int j = i - 24576; *(v4u*)(WQKV + (size_t)(768 + (j >> 5)) * 384 + (j & 31) * 8) = z4; }
    }
}
__device__ __forceinline__ float siluf_(float x) { return x / (1.0f + __expf(-x)); }
__device__ __forceinline__ void mod_gemv(const Args& a, LAS unsigned char* lds, int G) {
    const int tid = threadIdx.x, lane = tid & 63, wave = tid >> 6;
    float* MOD = (float*)(a.ws + WS_MOD);
    LAS float* sl = (LAS float*)lds;
    LAS float* red = (LAS float*)(lds + 40960);
    if ((int)blockIdx.x < 192) {
        for (int i = tid; i < 9 * 1024; i += 512) { const float v = (i < 8192) ? a.c[i] : a.c_ctx[i - 8192]; sl[i] = siluf_(v); }
        __syncthreads();
    }
    for (int item = blockIdx.x; item < 192; item += G) {
        const int l = item / 96, n0 = (item % 96) * 64;
        float acc[9];
#pragma unroll
        for (int r = 0; r < 9; ++r) acc[r] = 0.f;
        const float* wp = a.w_mod + ((size_t)l * 1024 + wave * 128) * 6144 + n0 + lane;
#pragma unroll 8
        for (int k = 0; k < 128; ++k) {
            const float w = wp[(size_t)k * 6144]; const int kk = wave * 128 + k;
#pragma unroll
            for (int r = 0; r < 9; ++r) acc[r] += sl[r * 1024 + kk] * w;
        }
#pragma unroll
        for (int r = 0; r < 9; ++r) red[(wave * 9 + r) * 64 + lane] = acc[r];
        __syncthreads();
        for (int idx = tid; idx < 576; idx += 512) { const int r = idx >> 6, ln = idx & 63; float s = a.b_mod[l * 6144 + n0 + ln];
#pragma unroll
            for (int w = 0; w < 8; ++w) s += red[(w * 9 + r) * 64 + ln];
            MOD[((size_t)l * 9 + r) * 6144 + n0 + ln] = s; }
        __syncthreads();
    }
}

__device__ __forceinline__ void modulate_rows(const float* x_lat, const float* x_ctx, const float* gn, const float* mod_l, int sel_shift, int sel_scale, bf16* H, int G) {
    const int tid = threadIdx.x, lane = tid & 63, wave = tid >> 6; const int gw = blockIdx.x * NWAVES + wave, NGW = G * NWAVES;
    for (int tok0 = gw; tok0 < T; tok0 += 2 * NGW) {
        const int tokB = (tok0 + NGW < T) ? tok0 + NGW : tok0; const bool two = tokB != tok0;
        const int bA = tok0 / TPB, pA = tok0 - bA * TPB, bB = tokB / TPB, pB = tokB - bB * TPB;
        const float* xA = (pA < CTX) ? x_ctx + ((size_t)bA * CTX + pA) * DM : x_lat + ((size_t)bA * SEQ + (pA - CTX)) * DM;
        const float* xB = (pB < CTX) ? x_ctx + ((size_t)bB * CTX + pB) * DM : x_lat + ((size_t)bB * SEQ + (pB - CTX)) * DM;
        const float* mA = mod_l + (size_t)((pA < CTX) ? 8 : bA) * 6144; const float* mB = mod_l + (size_t)((pB < CTX) ? 8 : bB) * 6144;
        f32x4 vA[4], vB[4]; float sA = 0.f, sB = 0.f;
#pragma unroll
        for (int j = 0; j < 4; ++j) vA[j] = __builtin_nontemporal_load((const f32x4*)(xA + 4 * lane + 256 * j));
#pragma unroll
        for (int j = 0; j < 4; ++j) vB[j] = __builtin_nontemporal_load((const f32x4*)(xB + 4 * lane + 256 * j));
#pragma unroll
        for (int j = 0; j < 4; ++j) { sA += (vA[j].x * vA[j].x + vA[j].y * vA[j].y) + (vA[j].z * vA[j].z + vA[j].w * vA[j].w); sB += (vB[j].x * vB[j].x + vB[j].y * vB[j].y) + (vB[j].z * vB[j].z + vB[j].w * vB[j].w); }
        const float rA = rsqrtf(wave_sum(sA) * (1.f / DM) + EPS), rB = rsqrtf(wave_sum(sB) * (1.f / DM) + EPS);
#pragma unroll
        for (int j = 0; j < 4; ++j) { const int c = 4 * lane + 256 * j; const f32x4 g = *(const f32x4*)(gn + c);
            { const f32x4 sh = *(const f32x4*)(mA + sel_shift * 1024 + c), sc = *(const f32x4*)(mA + sel_scale * 1024 + c); const f32x4 y = (vA[j] * rA * g) * (sc + 1.0f) + sh;
              v2u o; o.x = pk2(y.x, y.y); o.y = pk2(y.z, y.w); *(v2u*)(H + (size_t)tok0 * DM + c) = o; }
            if (two) { const f32x4 sh = *(const f32x4*)(mB + sel_shift * 1024 + c), sc = *(const f32x4*)(mB + sel_scale * 1024 + c); const f32x4 y = (vB[j] * rB * g) * (sc + 1.0f) + sh;
              v2u o; o.x = pk2(y.x, y.y); o.y = pk2(y.z, y.w); *(v2u*)(H + (size_t)tokB * DM + c) = o; }
        }
    }
}
__device__ __forceinline__ void head_pass(bf16* base, int nheads, bool norm, const float* gain, float oscale, bool lat, float prow, float pcol, int lane) {
    const int hd = lane >> 3, sub = lane & 7, axis = sub >> 2, fg = sub & 3; const bool active = hd < nheads;
    bf16* p0 = base + hd * 64 + axis * 32 + 4 * fg; bf16* p1 = p0 + 16;
    float x0[4] = {0.f, 0.f, 0.f, 0.f}, x1[4] = {0.f, 0.f, 0.f, 0.f};
    if (active) { const v2u a = __builtin_nontemporal_load((const v2u*)p0), b = __builtin_nontemporal_load((const v2u*)p1); x0[0] = blo(a.x); x0[1] = bhi(a.x); x0[2] = blo(a.y); x0[3] = bhi(a.y); x1[0] = blo(b.x); x1[1] = bhi(b.x); x1[2] = blo(b.y); x1[3] = bhi(b.y); }
    if (norm) {
        float ss = 0.f;
#pragma unroll
        for (int i = 0; i < 4; ++i) ss += x0[i] * x0[i] + x1[i] * x1[i];
        ss += __shfl_xor(ss, 1); ss += __shfl_xor(ss, 2); ss += __shfl_xor(ss, 4);
        const float rstd = rsqrtf(ss * (1.f / 64.f) + EPS);
#pragma unroll
        for (int i = 0; i < 4; ++i) { x0[i] *= rstd * gain[axis * 32 + 4 * fg + i]; x1[i] *= rstd * gain[axis * 32 + 16 + 4 * fg + i]; }
    }
    if (lat) { const float pos = axis ? pcol : prow;
#pragma unroll
        for (int i = 0; i < 4; ++i) { const float inv = __builtin_amdgcn_exp2f(-(float)(4 * fg + i) * (L2_THETA / 16.f)); const float ang = pos * inv, cs = __cosf(ang), sn = __sinf(ang);
            const float y0 = x0[i] * cs - x1[i] * sn, y1 = x1[i] * cs + x0[i] * sn; x0[i] = y0; x1[i] = y1; } }
    if (active) { v2u a, b; a.x = pk2(x0[0] * oscale, x0[1] * oscale); a.y = pk2(x0[2] * oscale, x0[3] * oscale); b.x = pk2(x1[0] * oscale, x1[1] * oscale); b.y = pk2(x1[2] * oscale, x1[3] * oscale);
        *(v2u*)p0 = a; *(v2u*)p1 = b; }
}
__device__ __forceinline__ void post_proj_rows(const Args& a, int l, bf16* R, bf16* AQKV, int G) {
    const int tid = threadIdx.x, lane = tid & 63, wave = tid >> 6; const int gw = blockIdx.x * NWAVES + wave, NGW = G * NWAVES;
    const float qs = 0.125f * LOG2E;
    for (int tok = gw; tok < T; tok += NGW) {
        const int b = tok / TPB, p = tok - b * TPB; const bool lat = p >= CTX; const int n = p - CTX; const float prow = (float)(n >> 6), pcol = (float)(n & 63);
        bf16* Rr = R + (size_t)tok * RW; bf16* Ar = AQKV + (size_t)tok * 384;
        { const v2u w = *(const v2u*)(Rr + 4 * lane); const float f0 = blo(w.x), f1 = bhi(w.x), f2 = blo(w.y), f3 = bhi(w.y);
          const float rstd = rsqrtf(wave_sum(f0 * f0 + f1 * f1 + f2 * f2 + f3 * f3) * (1.f / 256.f) + EPS);
          const f32x4 g = *(const f32x4*)(a.g_q_a + l * 256 + 4 * lane);
          v2u o; o.x = pk2(f0 * rstd * g.x, f1 * rstd * g.y); o.y = pk2(f2 * rstd * g.z, f3 * rstd * g.w); *(v2u*)(Ar + 4 * lane) = o; }
        { const unsigned w = *(const unsigned*)(Rr + 256 + 2 * lane); const float f0 = blo(w), f1 = bhi(w);
          const float rstd = rsqrtf(wave_sum(f0 * f0 + f1 * f1) * (1.f / 128.f) + EPS);
          const float g0 = a.g_kv_a[l * 128 + 2 * lane], g1 = a.g_kv_a[l * 128 + 2 * lane + 1];
          *(unsigned*)(Ar + 256 + 2 * lane) = pk2(f0 * rstd * g0, f1 * rstd * g1); }
        if (lat && lane < 16) { const int axis = lane >> 3, f = lane & 7; bf16* q0 = Rr + 384 + axis * 16 + f; bf16* q1 = q0 + 8;
          const float x0 = blo((unsigned)*q0), x1 = blo((unsigned)*q1); const float pos = axis ? pcol : prow;
          const float inv = __builtin_amdgcn_exp2f(-(float)f * (L2_THETA / 8.f)); const float ang = pos * inv, cs = __cosf(ang), sn = __sinf(ang);
          *q0 = (bf16)f2bf(x0 * cs - x1 * sn); *q1 = (bf16)f2bf(x1 * cs + x0 * sn); }
        head_pass(Rr + 416, 8, true, a.g_qn + l * 64, qs, lat, prow, pcol, lane);
        head_pass(Rr + 928, 2, true, a.g_kn + l * 64, 1.f, lat, prow, pcol, lane);
        head_pass(Rr + 1184, 8, false, nullptr, qs, lat, prow, pcol, lane);
        head_pass(Rr + 1696, 2, false, nullptr, 1.f, lat, prow, pcol, lane);
    }
}
__device__ __forceinline__ void conv_act(const Args& a, int l, int half, const bf16* U, bf16* ACT, int G) {
    const int gt = blockIdx.x * 512 + threadIdx.x, NGT = G * 512;
    const float* wc = a.w_conv + (size_t)l * 3 * NUP; const float* bc = a.b_conv + (size_t)l * NUP;
    constexpr int NCG = DFF / 8, NRUN = THALF / 32;
    for (int item = gt; item < NRUN * NCG; item += NGT) {
        const int run = item / NCG, cgp = item - run * NCG, c = 8 * cgp;
        const int lrow0 = run * 32, tok0 = half * THALF + lrow0; const int p = tok0 % TPB;
        const bool first = (p == 0) || (p == CTX); const bool lastrun = (p + 32 == CTX) || (p + 32 == TPB);
        float wa[3][8], wg[3][8], ba[8], bg[8];
#pragma unroll
        for (int j = 0; j < 3; ++j) { const f32x4 t0 = *(const f32x4*)(wc + j * NUP + c), t1 = *(const f32x4*)(wc + j * NUP + c + 4), t2 = *(const f32x4*)(wc + j * NUP + DFF + c), t3 = *(const f32x4*)(wc + j * NUP + DFF + c + 4);
#pragma unroll
            for (int e = 0; e < 4; ++e) { wa[j][e] = t0[e]; wa[j][4 + e] = t1[e]; wg[j][e] = t2[e]; wg[j][4 + e] = t3[e]; } }
        { const f32x4 t0 = *(const f32x4*)(bc + c), t1 = *(const f32x4*)(bc + c + 4), t2 = *(const f32x4*)(bc + DFF + c), t3 = *(const f32x4*)(bc + DFF + c + 4);
#pragma unroll
            for (int e = 0; e < 4; ++e) { ba[e] = t0[e]; ba[4 + e] = t1[e]; bg[e] = t2[e]; bg[4 + e] = t3[e]; } }
        const v4u z4 = (v4u){0u, 0u, 0u, 0u};
        const bf16* up = U + (size_t)lrow0 * NUP + c;
        v4u pa = z4, pg = z4; if (!first) { pa = __builtin_nontemporal_load((const v4u*)(up - NUP)); pg = __builtin_nontemporal_load((const v4u*)(up - NUP + DFF)); }
        v4u ca = __builtin_nontemporal_load((const v4u*)up), cgv = __builtin_nontemporal_load((const v4u*)(up + DFF));
        for (int i = 0; i < 32; ++i) {
            v4u na = z4, ng = z4; if (!(lastrun && i == 31)) { na = __builtin_nontemporal_load((const v4u*)(up + (size_t)(i + 1) * NUP)); ng = __builtin_nontemporal_load((const v4u*)(up + (size_t)(i + 1) * NUP + DFF)); }
            v4u o;
#pragma unroll
            for (int e = 0; e < 4; ++e) {
                const float a0 = blo(pa[e]) * wa[0][2 * e] + blo(ca[e]) * wa[1][2 * e] + blo(na[e]) * wa[2][2 * e] + ba[2 * e];
                const float a1 = bhi(pa[e]) * wa[0][2 * e + 1] + bhi(ca[e]) * wa[1][2 * e + 1] + bhi(na[e]) * wa[2][2 * e + 1] + ba[2 * e + 1];
                const float g0 = blo(pg[e]) * wg[0][2 * e] + blo(cgv[e]) * wg[1][2 * e] + blo(ng[e]) * wg[2][2 * e] + bg[2 * e];
                const float g1 = bhi(pg[e]) * wg[0][2 * e + 1] + bhi(cgv[e]) * wg[1][2 * e + 1] + bhi(ng[e]) * wg[2][2 * e + 1] + bg[2 * e + 1];
                o[e] = pk2(siluf_(a0) * g0, siluf_(a1) * g1);
            }
            *(v4u*)(ACT + (size_t)(tok0 + i) * DFF + c) = o;
            pa = ca; pg = cgv; ca = na; cgv = ng;
        }
    }
}
__device__ __forceinline__ void final_norm(const Args& a, int G) {
    const int tid = threadIdx.x, lane = tid & 63, wave = tid >> 6; const int gw = blockIdx.x * NWAVES + wave, NGW = G * NWAVES;
    for (int row0 = gw; row0 < NB * SEQ; row0 += 2 * NGW) {
        const int rowB = (row0 + NGW < NB * SEQ) ? row0 + NGW : row0; const bool two = rowB != row0;
        float* xA = a.out + (size_t)row0 * DM; float* xB = a.out + (size_t)rowB * DM;
        f32x4 vA[4], vB[4]; float sA = 0.f, sB = 0.f;
#pragma unroll
        for (int j = 0; j < 4; ++j) vA[j] = __builtin_nontemporal_load((const f32x4*)(xA + 4 * lane + 256 * j));
#pragma unroll
        for (int j = 0; j < 4; ++j) vB[j] = __builtin_nontemporal_load((const f32x4*)(xB + 4 * lane + 256 * j));
#pragma unroll
        for (int j = 0; j < 4; ++j) { sA += (vA[j].x * vA[j].x + vA[j].y * vA[j].y) + (vA[j].z * vA[j].z + vA[j].w * vA[j].w); sB += (vB[j].x * vB[j].x + vB[j].y * vB[j].y) + (vB[j].z * vB[j].z + vB[j].w * vB[j].w); }
        const float rA = rsqrtf(wave_sum(sA) * (1.f / DM) + EPS), rB = rsqrtf(wave_sum(sB) * (1.f / DM) + EPS);
#pragma unroll
        for (int j = 0; j < 4; ++j) { const int c = 4 * lane + 256 * j; const f32x4 g = *(const f32x4*)(a.g_final + c);
            __builtin_nontemporal_store(vA[j] * rA * g, (f32x4*)(xA + c));
            if (two) __builtin_nontemporal_store(vB[j] * rB * g, (f32x4*)(xB + c)); }
    }
}
#define XB_TMO      128
#define XB_XCNT(j)  (256  + 64 * (j))
#define XB_XSUB(j)  (1280 + 64 * (j))
#define XB_XGEN(j)  (2304 + 64 * (j))
#define XB_TOP      3328
#define XB_TOPGEN   3392
#define XCD_BAR_WORDS 3456
#define XB_SPIN_CAP (1u << 18)

__device__ __forceinline__ unsigned xb_ld(unsigned* p)              { return __hip_atomic_load(p, __ATOMIC_RELAXED, __HIP_MEMORY_SCOPE_AGENT); }
__device__ __forceinline__ unsigned xb_add(unsigned* p, unsigned v) { return __hip_atomic_fetch_add(p, v, __ATOMIC_RELAXED, __HIP_MEMORY_SCOPE_AGENT); }
__device__ __forceinline__ unsigned xb_xcc_id() { return (unsigned)__builtin_amdgcn_s_getreg((3 << 11) | 20) & 0xFu; }
#define XB_SPIN(cond, bar) do { unsigned _sp = 0; while (cond) { __builtin_amdgcn_s_sleep(1); \
    if ((++_sp & 255u) == 0u) { if (xb_ld(&(bar)[XB_TMO])) break; if (_sp > XB_SPIN_CAP) { atomicAdd(&(bar)[XB_TMO], 1u); break; } } } } while (0)

struct XcdBarrier {
    unsigned* bar; unsigned x;
    volatile LAS unsigned* st;
};

__device__ __forceinline__ XcdBarrier xcd_barrier_post(unsigned* bar, volatile LAS unsigned* st) {
    XcdBarrier b; b.bar = bar; b.x = xb_xcc_id(); b.st = st;
    if (threadIdx.x == 0) (void)xb_add(&bar[XB_XCNT(b.x)], 1u);
    return b;
}
__device__ __forceinline__ void xcd_barrier_complete(unsigned* bar, unsigned x, unsigned& nloc, unsigned& nx) {
    const unsigned G = gridDim.x * gridDim.y * gridDim.z;
    unsigned sum, cnt, mine, sp = 0u;
    for (;;) {
        sum = 0u; cnt = 0u; mine = 0u;
#pragma unroll
        for (unsigned j = 0; j < 16; ++j) { const unsigned c = xb_ld(&bar[XB_XCNT(j)]); sum += c; cnt += (c > 0u) ? 1u : 0u; mine = (j == x) ? c : mine; }
        if (sum == G) break;
        __builtin_amdgcn_s_sleep(1);
        if ((++sp & 255u) == 0u) { if (xb_ld(&bar[XB_TMO])) break; if (sp > XB_SPIN_CAP) { atomicAdd(&bar[XB_TMO], 1u); break; } }
    }
    nloc = mine > 0u ? mine : 1u; nx = cnt > 0u ? cnt : 1u;
}

__device__ __forceinline__ void xcd_barrier(const XcdBarrier& b) {
    asm volatile("s_waitcnt vmcnt(0)" ::: "memory");
    __syncthreads();
    if (threadIdx.x == 0) {
        unsigned* bar = b.bar;
        __builtin_amdgcn_s_waitcnt(0);
        unsigned nloc = b.st[0], nx = b.st[1];
        if (nloc == 0u) { xcd_barrier_complete(bar, b.x, nloc, nx); b.st[0] = nloc; b.st[1] = nx; }
        const unsigned old = xb_add(&bar[XB_XSUB(b.x)], 1u);
        const unsigned gen = old / nloc;
        if (old + 1u == (gen + 1u) * nloc) {
            __builtin_amdgcn_fence(__ATOMIC_RELEASE, "agent");
            asm volatile("s_waitcnt vmcnt(0)" ::: "memory");
            const unsigned og = xb_add(&bar[XB_TOP], 1u);
            const unsigned tg = og / nx;
            if (og + 1u == (tg + 1u) * nx) xb_add(&bar[XB_TOPGEN], 1u);
            else XB_SPIN(xb_ld(&bar[XB_TOPGEN]) == tg, bar);
            __builtin_amdgcn_fence(__ATOMIC_ACQUIRE, "agent");
            xb_add(&bar[XB_XGEN(b.x)], 1u);
            asm volatile("s_waitcnt vmcnt(0)" ::: "memory");
        } else {
            XB_SPIN(xb_ld(&bar[XB_XGEN(b.x)]) == gen, bar);
            __builtin_amdgcn_fence(__ATOMIC_ACQUIRE, "agent");
            asm volatile("s_waitcnt vmcnt(0)" ::: "memory");
        }
    }
    __syncthreads();
}

__device__ __forceinline__ int crow(int r, int hi) { return (r & 3) + 8 * (r >> 2) + 4 * hi; }
typedef short v4i16_t __attribute__((ext_vector_type(4)));
__device__ __forceinline__ s16x4 vtr(const LAS unsigned char* p) { return __builtin_bit_cast(s16x4, __builtin_amdgcn_ds_read_tr16_b64_v4i16((LAS v4i16_t*)p)); }
__device__ __forceinline__ unsigned cvtpk(float lo, float hi) { return pg8::cvt_pk_bf16(lo, hi); }

template <int MIX>
__device__ __forceinline__ void attn_unit(LAS unsigned char* lds, const bf16* R, const bf16* QKVA, bf16* Oall, const float* sink, int b, int h, int qb) {
    constexpr int DK = (MIX == 0) ? 96 : 64, ND = DK / 16, KCH = DK / 8;
    constexpr int KSTR = DK * 2 + 16, VSTR = 192, KBUF = 64 * KSTR, VBUF = 64 * VSTR;
    int tid_ = threadIdx.x; asm volatile("" : "+v"(tid_));
    const int tid = tid_, lane = tid & 63, wid = tid >> 6, r32 = lane & 31, hi = lane >> 5;
    const bool isctx = qb < 0;
    const int p0 = isctx ? 0 : CTX + 256 * qb;
    const size_t tokb = (size_t)b * TPB;
    const size_t qtok = tokb + p0 + wid * 32 + r32;
    const int nq = p0 - CTX + wid * 32 + r32;
    bf16x8 qr[ND];
    if (MIX == 0) {
        const bf16* qp = QKVA + qtok * QW + h * 96;
        const float qs = 0.10206207261596575f * LOG2E;
#pragma unroll
        for (int d0 = 0; d0 < ND; ++d0) {
            const v4u w = *(const v4u*)(qp + 16 * d0 + 8 * hi);
            float f[8] = {blo(w.x), bhi(w.x), blo(w.y), bhi(w.y), blo(w.z), bhi(w.z), blo(w.w), bhi(w.w)};
            if (d0 >= 4) {
                const float pos = isctx ? 0.f : ((d0 == 4) ? (float)(nq >> 6) : (float)(nq & 63));
#pragma unroll
                for (int j = 0; j < 8; ++j) { const float inv = __builtin_amdgcn_exp2f(-(float)j * (L2_THETA / 8.f)); const float ang = pos * inv, cs = __cosf(ang), sn = __sinf(ang);
                    const float pr = __shfl_xor(f[j], 32); f[j] = hi ? (f[j] * cs + pr * sn) : (f[j] * cs - pr * sn); }
            }
            v4u o; o.x = pk2(f[0] * qs, f[1] * qs); o.y = pk2(f[2] * qs, f[3] * qs); o.z = pk2(f[4] * qs, f[5] * qs); o.w = pk2(f[6] * qs, f[7] * qs);
            qr[d0] = __builtin_bit_cast(bf16x8, o);
        }
    } else {
        const bf16* qp = R + qtok * RW + (MIX == 1 ? 416 : 1184) + h * 64;
#pragma unroll
        for (int d0 = 0; d0 < ND; ++d0) qr[d0] = *(const bf16x8*)(qp + 16 * d0 + 8 * hi);
    }
    const bf16 *k0p, *k1p, *vp; int k0s, vs;
    if (MIX == 0) { k0p = QKVA + tokb * QW + 768 + h * 128; k0s = QW; k1p = R + tokb * RW + 384; vp = k0p + 64; vs = QW; }
    else { const int hk = h >> 2; k0p = R + tokb * RW + (MIX == 1 ? 928 : 1696) + hk * 64; k0s = RW; k1p = k0p; vp = R + tokb * RW + (MIX == 1 ? 1056 : 1824) + hk * 64; vs = RW; }
    int nt, wlo = 0;
    if (isctx) nt = 4;
    else if (MIX == 2) { const int n0 = 256 * qb; wlo = (n0 - 128 > 0 ? n0 - 128 : 0) >> 6; const int whi = (n0 + 384 < SEQ ? n0 + 384 : SEQ) >> 6; nt = 4 + (whi - wlo); }
    else nt = TPB / 64;
#define TILE_P0(ti) ((MIX == 2 && !isctx && (ti) >= 4) ? CTX + 64 * (wlo + (ti) - 4) : 64 * (ti))
    const int kr0 = tid / KCH, kc0 = tid - kr0 * KCH; const int kr1 = (tid + 512) / KCH, kc1 = (tid + 512) - kr1 * KCH; const bool k2 = (MIX == 0) && (tid < 256);
    const int vr = tid >> 3, vc = tid & 7;
    v4u kreg0, kreg1 = (v4u){0u, 0u, 0u, 0u}, vreg;
#define LOAD_TILE(ti) do { const int pk_ = TILE_P0(ti); \
        kreg0 = (MIX == 0 && kc0 >= 8) ? *(const v4u*)(k1p + (size_t)(pk_ + kr0) * RW + 8 * (kc0 - 8)) : *(const v4u*)(k0p + (size_t)(pk_ + kr0) * k0s + 8 * kc0); \
        if (k2) kreg1 = (kc1 >= 8) ? *(const v4u*)(k1p + (size_t)(pk_ + kr1) * RW + 8 * (kc1 - 8)) : *(const v4u*)(k0p + (size_t)(pk_ + kr1) * k0s + 8 * kc1); \
        vreg = *(const v4u*)(vp + (size_t)(pk_ + vr) * vs + 8 * vc); } while (0)
#define STORE_TILE(bufi) do { LAS unsigned char* kb_ = lds + (bufi) * KBUF; LAS unsigned char* vb_ = lds + 2 * KBUF + (bufi) * VBUF; \
        *(LAS v4u*)(kb_ + kr0 * KSTR + kc0 * 16) = kreg0; if (k2) *(LAS v4u*)(kb_ + kr1 * KSTR + kc1 * 16) = kreg1; \
        *(LAS v4u*)(vb_ + vr * VSTR + vc * 16) = vreg; } while (0)
    constexpr float THR = 8.0f; constexpr int NKA = (ND > 4) ? 3 : 4;
    float m_ref = 0.f, l_run = 0.f;
    if (MIX == 2) l_run = hi ? 0.f : __builtin_amdgcn_exp2f(sink[h] * LOG2E);
    f32x16 negm;
#pragma unroll
    for (int r = 0; r < 16; ++r) negm[r] = 0.f;
    f32x16 o[2];
#pragma unroll
    for (int r = 0; r < 16; ++r) { o[0][r] = 0.f; o[1][r] = 0.f; }
    const LAS unsigned char* kbase = lds + r32 * KSTR + hi * 16;
    const LAS unsigned char* vbase = lds + 2 * KBUF + (4 * hi + ((lane & 15) >> 2)) * VSTR + (16 * ((lane >> 4) & 1) + 4 * (lane & 3)) * 2;
#define LOAD_K(ti, K0, K1) do { const int pk_ = TILE_P0(ti); \
        K0 = (MIX == 0 && kc0 >= 8) ? *(const v4u*)(k1p + (size_t)(pk_ + kr0) * RW + 8 * (kc0 - 8)) : *(const v4u*)(k0p + (size_t)(pk_ + kr0) * k0s + 8 * kc0); \
        if (k2) K1 = (kc1 >= 8) ? *(const v4u*)(k1p + (size_t)(pk_ + kr1) * RW + 8 * (kc1 - 8)) : *(const v4u*)(k0p + (size_t)(pk_ + kr1) * k0s + 8 * kc1); } while (0)
#define LOAD_V(ti, V0) do { const int pk_ = TILE_P0(ti); V0 = *(const v4u*)(vp + (size_t)(pk_ + vr) * vs + 8 * vc); } while (0)
#define STORE_K(bufi, K0, K1) do { LAS unsigned char* kb_ = lds + (bufi) * KBUF; *(LAS v4u*)(kb_ + kr0 * KSTR + kc0 * 16) = K0; if (k2) *(LAS v4u*)(kb_ + kr1 * KSTR + kc1 * 16) = K1; } while (0)
#define STORE_V(bufi, V0) do { *(LAS v4u*)(lds + 2 * KBUF + (bufi) * VBUF + vr * VSTR + vc * 16) = V0; } while (0)
#define QK_PAIR(S0, S1, KB, d0) do { const bf16x8 kf0_ = *(const LAS bf16x8*)((KB) + (d0) * 32), kf1_ = *(const LAS bf16x8*)((KB) + 32 * KSTR + (d0) * 32); \
        S0 = __builtin_amdgcn_mfma_f32_32x32x16_bf16(kf0_, qr[d0], (d0) == 0 ? negm : S0, 0, 0, 0); S1 = __builtin_amdgcn_mfma_f32_32x32x16_bf16(kf1_, qr[d0], (d0) == 0 ? negm : S1, 0, 0, 0); } while (0)
#define MASK_TILE(S0, S1, ti) do { if (MIX == 2 && !isctx && (ti) >= 4) { const int nk0_ = 64 * (wlo + (ti) - 4) - nq; \
        _Pragma("unroll") for (int r = 0; r < 16; ++r) { const int d_ = nk0_ + crow(r, hi); if (d_ > 128 || d_ < -128) S0[r] = -INFINITY; if (d_ + 32 > 128 || d_ + 32 < -128) S1[r] = -INFINITY; } } } while (0)
#define DECIDE_MAX(S0, S1, RM) float RM; do { float a_ = __builtin_fmaxf(__builtin_fmaxf(S0[0], S0[1]), S0[2]), b_ = __builtin_fmaxf(__builtin_fmaxf(S0[3], S0[4]), S0[5]), c_ = __builtin_fmaxf(__builtin_fmaxf(S1[0], S1[1]), S1[2]), d_ = __builtin_fmaxf(__builtin_fmaxf(S1[3], S1[4]), S1[5]); \
        a_ = __builtin_fmaxf(__builtin_fmaxf(a_, S0[6]), S0[7]); b_ = __builtin_fmaxf(__builtin_fmaxf(b_, S0[8]), S0[9]); c_ = __builtin_fmaxf(__builtin_fmaxf(c_, S1[6]), S1[7]); d_ = __builtin_fmaxf(__builtin_fmaxf(d_, S1[8]), S1[9]); \
        a_ = __builtin_fmaxf(__builtin_fmaxf(a_, S0[10]), S0[11]); b_ = __builtin_fmaxf(__builtin_fmaxf(b_, S0[12]), S0[13]); c_ = __builtin_fmaxf(__builtin_fmaxf(c_, S1[10]), S1[11]); d_ = __builtin_fmaxf(__builtin_fmaxf(d_, S1[12]), S1[13]); \
        a_ = __builtin_fmaxf(__builtin_fmaxf(a_, S0[14]), S0[15]); c_ = __builtin_fmaxf(__builtin_fmaxf(c_, S1[14]), S1[15]); a_ = __builtin_fmaxf(a_, c_); b_ = __builtin_fmaxf(b_, d_); \
        float rm_ = __builtin_fmaxf(a_, b_); { const auto rr_ = __builtin_amdgcn_permlane32_swap(__builtin_bit_cast(unsigned, rm_), __builtin_bit_cast(unsigned, rm_), false, false); rm_ = __builtin_fmaxf(__builtin_bit_cast(float, (unsigned)rr_[0]), __builtin_bit_cast(float, (unsigned)rr_[1])); } RM = rm_; } while (0)
#define DECIDE_APPLY(S0, S1, RM) do { const float rm_ = RM; \
        if (__builtin_expect(__any(rm_ > THR), 0)) { const float dl_ = __builtin_fmaxf(rm_, 0.f); m_ref += dl_; \
            _Pragma("unroll") for (int r = 0; r < 16; ++r) { S0[r] -= dl_; S1[r] -= dl_; negm[r] = -m_ref; } \
            const float f_ = __builtin_amdgcn_exp2f(-dl_); l_run *= f_; \
            _Pragma("unroll") for (int r = 0; r < 16; ++r) { o[0][r] *= f_; o[1][r] *= f_; } } } while (0)
    f32x16 sA0, sA1, sB0, sB1;
    { v4u kp0_, kp1_ = (v4u){0u, 0u, 0u, 0u}; LOAD_K(0, kreg0, kreg1); LOAD_V(0, vreg); LOAD_K(1, kp0_, kp1_);
      STORE_K(0, kreg0, kreg1); STORE_V(0, vreg); STORE_K(1, kp0_, kp1_); }
    __syncthreads();
#pragma unroll
    for (int d0 = 0; d0 < ND; ++d0) QK_PAIR(sA0, sA1, kbase, d0);
    MASK_TILE(sA0, sA1, 0);
    { DECIDE_MAX(sA0, sA1, rm0_); DECIDE_APPLY(sA0, sA1, rm0_); }
    __syncthreads();
#define QK_MM(S0, S1, d0) do { S0 = __builtin_amdgcn_mfma_f32_32x32x16_bf16(kfr[d0][0], qr[d0], (d0) == 0 ? negm : S0, 0, 0, 0); S1 = __builtin_amdgcn_mfma_f32_32x32x16_bf16(kfr[d0][1], qr[d0], (d0) == 0 ? negm : S1, 0, 0, 0); } while (0)
#define STEP(C0, C1, N0, N1, t, LK0, LK1, LV, SK0, SK1, SV) do { \
        if ((t) + 2 < nt) LOAD_K((t) + 2, LK0, LK1); if ((t) + 1 < nt) LOAD_V((t) + 1, LV); \
        const LAS unsigned char* kb_n = kbase + (((t) + 1) & 1) * KBUF; const LAS unsigned char* vb_c = vbase + ((t) & 1) * VBUF; \
        float sum_ = 0.f, sum1_ = 0.f, sum2_ = 0.f, sum3_ = 0.f; bf16x8 pf[4]; v4u w_; bf16x8 kfr[ND][2]; \
        _Pragma("unroll") for (int d0 = 0; d0 < NKA; ++d0) { kfr[d0][0] = *(const LAS bf16x8*)(kb_n + d0 * 32); kfr[d0][1] = *(const LAS bf16x8*)(kb_n + 32 * KSTR + d0 * 32); } \
        _Pragma("unroll") for (int r = 0; r < 8; ++r) C0[r] = __builtin_amdgcn_exp2f(C0[r]); \
        sum_ += (C0[0] + C0[1]) + (C0[2] + C0[3]); sum1_ += (C0[4] + C0[5]) + (C0[6] + C0[7]); \
        QK_MM(N0, N1, 0); \
        _Pragma("unroll") for (int r = 8; r < 16; ++r) C0[r] = __builtin_amdgcn_exp2f(C0[r]); \
        sum2_ += (C0[8] + C0[9]) + (C0[10] + C0[11]); sum3_ += (C0[12] + C0[13]) + (C0[14] + C0[15]); \
        QK_MM(N0, N1, 1); \
        if (ND > NKA) { _Pragma("unroll") for (int d0 = NKA; d0 < ND; ++d0) { kfr[d0][0] = *(const LAS bf16x8*)(kb_n + d0 * 32); kfr[d0][1] = *(const LAS bf16x8*)(kb_n + 32 * KSTR + d0 * 32); } } \
        _Pragma("unroll") for (int r = 0; r < 8; ++r) C1[r] = __builtin_amdgcn_exp2f(C1[r]); \
        sum_ += (C1[0] + C1[1]) + (C1[2] + C1[3]); sum1_ += (C1[4] + C1[5]) + (C1[6] + C1[7]); \
        QK_MM(N0, N1, 2); \
        _Pragma("unroll") for (int r = 8; r < 16; ++r) C1[r] = __builtin_amdgcn_exp2f(C1[r]); \
        sum2_ += (C1[8] + C1[9]) + (C1[10] + C1[11]); sum3_ += (C1[12] + C1[13]) + (C1[14] + C1[15]); \
        QK_MM(N0, N1, 3); \
        if (ND > 4) { QK_MM(N0, N1, (ND > 4 ? 4 : 0)); QK_MM(N0, N1, (ND > 4 ? 5 : 0)); } \
        s16x4 vlo_[4], vhi_[4], vlo2_[4], vhi2_[4]; \
        _Pragma("unroll") for (int s = 0; s < 2; ++s) _Pragma("unroll") for (int d0 = 0; d0 < 2; ++d0) { vlo_[2 * s + d0] = vtr(vb_c + (16 * s) * VSTR + d0 * 64); vhi_[2 * s + d0] = vtr(vb_c + (16 * s + 8) * VSTR + d0 * 64); } \
        w_.x = cvtpk(C0[0], C0[1]); w_.y = cvtpk(C0[2], C0[3]); w_.z = cvtpk(C0[4], C0[5]); w_.w = cvtpk(C0[6], C0[7]); pf[0] = __builtin_bit_cast(bf16x8, w_); \
        w_.x = cvtpk(C0[8], C0[9]); w_.y = cvtpk(C0[10], C0[11]); w_.z = cvtpk(C0[12], C0[13]); w_.w = cvtpk(C0[14], C0[15]); pf[1] = __builtin_bit_cast(bf16x8, w_); \
        w_.x = cvtpk(C1[0], C1[1]); w_.y = cvtpk(C1[2], C1[3]); w_.z = cvtpk(C1[4], C1[5]); w_.w = cvtpk(C1[6], C1[7]); pf[2] = __builtin_bit_cast(bf16x8, w_); \
        w_.x = cvtpk(C1[8], C1[9]); w_.y = cvtpk(C1[10], C1[11]); w_.z = cvtpk(C1[12], C1[13]); w_.w = cvtpk(C1[14], C1[15]); pf[3] = __builtin_bit_cast(bf16x8, w_); \
        l_run += (sum_ + sum1_) + (sum2_ + sum3_); \
        MASK_TILE(N0, N1, (t) + 1); DECIDE_MAX(N0, N1, rmn_); \
        _Pragma("unroll") for (int s = 2; s < 4; ++s) _Pragma("unroll") for (int d0 = 0; d0 < 2; ++d0) { vlo2_[2 * (s - 2) + d0] = vtr(vb_c + (16 * s) * VSTR + d0 * 64); vhi2_[2 * (s - 2) + d0] = vtr(vb_c + (16 * s + 8) * VSTR + d0 * 64); } \
        _Pragma("unroll") for (int s = 0; s < 2; ++s) _Pragma("unroll") for (int d0 = 0; d0 < 2; ++d0) { \
            const s16x4 lo_ = vlo_[2 * s + d0], hh_ = vhi_[2 * s + d0]; \
            const bf16x8 vf_ = (bf16x8){lo_[0], lo_[1], lo_[2], lo_[3], hh_[0], hh_[1], hh_[2], hh_[3]}; \
            o[d0] = __builtin_amdgcn_mfma_f32_32x32x16_bf16(vf_, pf[s], o[d0], 0, 0, 0); } \
        _Pragma("unroll") for (int s = 2; s < 4; ++s) _Pragma("unroll") for (int d0 = 0; d0 < 2; ++d0) { \
            const s16x4 lo_ = vlo2_[2 * (s - 2) + d0], hh_ = vhi2_[2 * (s - 2) + d0]; \
            const bf16x8 vf_ = (bf16x8){lo_[0], lo_[1], lo_[2], lo_[3], hh_[0], hh_[1], hh_[2], hh_[3]}; \
            o[d0] = __builtin_amdgcn_mfma_f32_32x32x16_bf16(vf_, pf[s], o[d0], 0, 0, 0); } \
        if ((t) + 1 < nt) { DECIDE_APPLY(N0, N1, rmn_); } \
        if ((t) + 2 < nt) STORE_K((t) & 1, SK0, SK1); if ((t) + 1 < nt) STORE_V(((t) + 1) & 1, SV); \
        __syncthreads(); } while (0)
    for (int ti = 0; ti < nt; ti += 2) {
        STEP(sA0, sA1, sB0, sB1, ti, kreg0, kreg1, vreg, kreg0, kreg1, vreg);
        STEP(sB0, sB1, sA0, sA1, ti + 1, kreg0, kreg1, vreg, kreg0, kreg1, vreg);
    }
#undef STEP
#undef QK_MM
#undef DECIDE_MAX
#undef DECIDE_APPLY
#undef MASK_TILE
#undef QK_PAIR
#undef LOAD_K
#undef LOAD_V
#undef STORE_K
#undef STORE_V
#undef LOAD_TILE
#undef STORE_TILE
#undef TILE_P0
    const float lt = l_run + __shfl_xor(l_run, 32); const float il = 1.0f / lt;
    LAS unsigned char* ost = lds + 65536 + wid * 4608;
#pragma unroll
    for (int d0 = 0; d0 < 2; ++d0)
#pragma unroll
        for (int g = 0; g < 4; ++g) { v2u w; w.x = cvtpk(o[d0][4 * g] * il, o[d0][4 * g + 1] * il); w.y = cvtpk(o[d0][4 * g + 2] * il, o[d0][4 * g + 3] * il);
            *(LAS v2u*)(ost + r32 * 144 + (32 * d0 + 8 * g + 4 * hi) * 2) = w; }
    asm volatile("s_waitcnt lgkmcnt(0)" ::: "memory");
    bf16* ob = Oall + ((size_t)MIX * T + (qtok - r32)) * 512 + h * 64;
#pragma unroll
    for (int it = 0; it < 4; ++it) { const int row = (lane >> 3) + 8 * it, ch = lane & 7;
        const v4u w = *(const LAS v4u*)(ost + row * 144 + ch * 16);
        *(v4u*)(ob + (size_t)row * 512 + ch * 8) = w; }
}
__device__ __forceinline__ void attn_phase(const Args& a, int l, LAS unsigned char* lds, const bf16* R, const bf16* QKVA, bf16* Oall, int G) {
    const int nlat = 3 * 1024, ntot = nlat + ((l == 0) ? 192 : 0);
    const float* sink = a.sink + l * 8;
    const int cperm = (G == 256) ? (((((int)blockIdx.x & 7) * 2 + ((int)blockIdx.x >> 7)) << 4) + (((int)blockIdx.x >> 3) & 15)) : (int)blockIdx.x;
    for (int u = cperm; u < ntot; u += G) {
        int mix, b, h, qb;
        if (u < nlat) { mix = u >> 10; const int v = u & 1023; qb = v & 15; h = (v >> 4) & 7; b = v >> 7; }
        else { const int w = u - nlat; mix = w >> 6; const int v = w & 63; h = v & 7; b = v >> 3; qb = -1; }
        if (mix == 0) attn_unit<0>(lds, R, QKVA, Oall, sink, b, h, qb);
        else if (mix == 1) attn_unit<1>(lds, R, QKVA, Oall, sink, b, h, qb);
        else attn_unit<2>(lds, R, QKVA, Oall, sink, b, h, qb);
    }
}


constexpr int NPH = 30;
#ifndef PHM
#define PHM 0xFFFFF
#endif
__global__ void __launch_bounds__(NWAVES * 64, 2) mega_fwd(Args a) {
    extern __shared__ __attribute__((aligned(16))) unsigned char lds_raw[];
    LAS unsigned char* lds = (LAS unsigned char*)lds_raw;
    cg::grid_group grid = cg::this_grid();
    if (a.ph_lo < 0) grid.sync();
    if (threadIdx.x < 4) ((LAS unsigned*)(lds + 131072))[threadIdx.x] = 0u;
    __syncthreads();
    XcdBarrier xbar = xcd_barrier_post((unsigned*)(a.ws + WS_BAR), (volatile LAS unsigned*)(lds + 131072));
    const int G = gridDim.x;
    unsigned char* ws = a.ws;
    float* MOD = (float*)(ws + WS_MOD); float* XCTX = (float*)(ws + WS_XCTX);
    unsigned char* wb = ws + WS_W; unsigned char* dyn = ws + WS_DYN;
    const bf16* WIN = (const bf16*)(wb + W_IN); const bf16* WG = (const bf16*)(wb + W_G); const bf16* WQKV = (const bf16*)(wb + W_QKV); const bf16* WBR = (const bf16*)(wb + W_BR);
    const bf16* WOUT = (const bf16*)(wb + W_OUT); const bf16* WUP = (const bf16*)(wb + W_UP); const bf16* WDN = (const bf16*)(wb + W_DN);
    bf16* H = (bf16*)(dyn + D_H); bf16* R = (bf16*)(dyn + D_R); bf16* QKVA = (bf16*)(dyn + D_QKVA); bf16* O = (bf16*)(dyn + D_O);
    bf16* AQKV = O; bf16* Gt = R; bf16* Y = H; bf16* H2 = H; bf16* U = (bf16*)(dyn + D_U); bf16* ACT = (bf16*)(dyn + D_ACT);

#define GSYNC() xcd_barrier(xbar)
#define RUN(PH) if (a.ph_lo <= (PH) && (PH) < a.ph_hi && ((void)(((PH) > a.ph_lo) ? (xcd_barrier(xbar), 0) : 0), true))
#ifdef DBG_LAYER
    if (blockIdx.x == 0 && threadIdx.x < 64) ((unsigned*)a.ws)[threadIdx.x] = 0u;
#endif
    RUN(0) { if (PHM & 4096) mod_gemv(a, lds, G); convert_weights(a, 0, lds, G); }
#ifdef DBG_LAYER
#ifndef DBG_SET
#define DBG_SET 1
#endif
#define DBGCHK(l, w) if ((l) == DBG_LAYER && a.ph_hi == NPH && (((w) < 20 && DBG_SET == 1) || ((w) >= 20 && (w) < 23 && DBG_SET == 2) || ((w) >= 23 && (w) < 30 && DBG_SET == 4) || ((w) >= 30 && DBG_SET == 3))) { GSYNC(); dbg_check(a, (l), (w)); }
#else
#define DBGCHK(l, w)
#endif
#define LAYER(l) do { \
    const float* modl = MOD + (size_t)(l) * 9 * 6144; \
    const float* xin_lat = ((l) == 0) ? a.x : a.out; const float* xin_ctx = ((l) == 0) ? a.ctx : XCTX; \
    RUN(1 + 14 * (l) + 0) { if (PHM & 1) { if ((l) == 1) convert_weights(a, 1, lds, G); modulate_rows(xin_lat, xin_ctx, a.g_norm1 + (l) * DM, modl, 0, 1, H, G); } } \
    RUN(1 + 14 * (l) + 1) { if (PHM & 2) { pg8::Gemm g{H, WIN, T, RW, DM, 0, 0}; pg8::TileSched S; S.init(NROWT, RW / 256, 1, G, (int)blockIdx.x, 0); \
        pg8::EpiStore<0> E{R, RW, nullptr, 0}; pg8::gemm_phase<pg8::EpiStore<0>, pg8::TileSched, true, true>(lds, g, S, E); } } \
    DBGCHK((l), 1) \
    DBGCHK((l), 26) \
    RUN(1 + 14 * (l) + 2) { if (PHM & 4) post_proj_rows(a, (l), R, AQKV, G); } \
    DBGCHK((l), 20) \
    RUN(1 + 14 * (l) + 3) { if (PHM & 8) { pg8::Gemm g{AQKV, WQKV, T, QW, 384, 0, 0}; pg8::TileSched S; S.init(NROWT, QW / 256, 1, G, (int)blockIdx.x, 0); \
        pg8::EpiStore<0> E{QKVA, QW, nullptr, 0}; pg8::gemm_phase<pg8::EpiStore<0>, pg8::TileSched, true, true>(lds, g, S, E); } } \
    DBGCHK((l), 2) \
    RUN(1 + 14 * (l) + 4) { if (PHM & 16) attn_phase(a, (l), lds, R, QKVA, O, G); } \
    DBGCHK((l), 3) \
    DBGCHK((l), 30) \
    RUN(1 + 14 * (l) + 5) { if (PHM & 32) { pg8::Gemm g{H, WG, T, 3072, DM, 0, 0}; pg8::TileSched S; S.init((l) ? 128 : NROWT, 12, 1, G, (int)blockIdx.x, 0, (l)); \
        pg8::EpiStore<2> E{Gt, 3072, a.b_gate + (l) * 3072, 0}; pg8::gemm_phase<pg8::EpiStore<2>, pg8::TileSched, true, true>(lds, g, S, E); } } \
    DBGCHK((l), 4) \
    DBGCHK((l), 33) \
    DBGCHK((l), 31) \
    RUN(1 + 14 * (l) + 6) { if (PHM & 64) { pg8::Gemm g{O, WBR, T, DM, 512, (size_t)T * 512 * 2, (size_t)1024 * 512 * 2}; pg8::TileSched S; S.init((l) ? 128 : NROWT, 4, 3, G, (int)blockIdx.x, 0, (l)); \
        pg8::EpiBranch E{Y, Gt}; pg8::gemm_phase<pg8::EpiBranch, pg8::TileSched, true, true>(lds, g, S, E); } } \
    DBGCHK((l), 5) \
    DBGCHK((l), 27) \
    RUN(1 + 14 * (l) + 7) { if (PHM & 128) { pg8::Gemm g{Y, WOUT, T, DM, DM, 0, 0}; pg8::TileSched S; S.init((l) ? 128 : NROWT, 4, 1, G, (int)blockIdx.x, 0, (l)); \
        pg8::EpiResid E{xin_lat, xin_ctx, a.out, XCTX, modl + 2 * 1024}; pg8::gemm_phase<pg8::EpiResid, pg8::TileSched, true, true>(lds, g, S, E); } } \
    DBGCHK((l), 6) \
    DBGCHK((l), 28) \
    RUN(1 + 14 * (l) + 8) { if (PHM & 256) modulate_rows(a.out, XCTX, a.g_norm2 + (l) * DM, modl, 3, 4, H2, G); } \
    DBGCHK((l), 25) \
    RUN(1 + 14 * (l) + 9) { if (PHM & 512) { pg8::Gemm g{H2, WUP, T, NUP, DM, 0, 0}; pg8::TileSched S; S.init(NROWT / 2, NUP / 256, 1, G, (int)blockIdx.x, 0); \
        pg8::EpiStore<0> E{U, NUP, nullptr, 0}; pg8::gemm_phase<pg8::EpiStore<0>, pg8::TileSched, true, true>(lds, g, S, E); } } \
    DBGCHK((l), 7) \
    RUN(1 + 14 * (l) + 10) { if (PHM & 1024) conv_act(a, (l), 0, U, ACT, G); } \
    DBGCHK((l), 8) \
    RUN(1 + 14 * (l) + 11) { if (PHM & 512) { pg8::Gemm g{H2, WUP, T, NUP, DM, 0, 0}; pg8::TileSched S; S.init(NROWT / 2, NUP / 256, 1, G, (int)blockIdx.x, NROWT / 2); \
        pg8::EpiStore<0> E{U, NUP, nullptr, THALF}; pg8::gemm_phase<pg8::EpiStore<0>, pg8::TileSched, true, true>(lds, g, S, E); } } \
    DBGCHK((l), 23) \
    RUN(1 + 14 * (l) + 12) { if (PHM & 1024) conv_act(a, (l), 1, U, ACT, G); } \
    DBGCHK((l), 21) \
    DBGCHK((l), 24) \
    RUN(1 + 14 * (l) + 13) { if (PHM & 2048) { pg8::Gemm g{ACT, WDN, T, DM, DFF, 0, 0}; pg8::TileSched S; S.init((l) ? 128 : NROWT, 4, 1, G, (int)blockIdx.x, 0, (l)); \
        pg8::EpiResid E{a.out, XCTX, a.out, XCTX, modl + 5 * 1024}; pg8::gemm_phase<pg8::EpiResid, pg8::TileSched, true, true>(lds, g, S, E); } } \
    DBGCHK((l), 22) \
    } while (0)
    LAYER(0);
    LAYER(1);
    RUN(NPH - 1) { final_norm(a, G); }
#ifdef DBG_LAYER
#ifndef DBG_NOREPORT
    GSYNC(); dbg_report(a);
#endif
#endif
#undef LAYER
#undef RUN
}

#ifndef MK_SINGLE
#define MK_SINGLE 1
#endif
extern "C" void kernel_launch(void* const* d_in, const int* in_sizes, int n_in, void* d_out, int out_size, void* d_ws, size_t ws_size, hipStream_t stream) {
    static int grid = 0;
    if (grid == 0) {
        if (n_in != 24 || ws_size < WS_END) { fprintf(stderr, "kernel_launch: need 24 inputs and %zu bytes of workspace (got %d, %zu)\n", (size_t)WS_END, n_in, ws_size); grid = -1; return; }
        int dev = 0, cus = 0, per_cu = 0;
        hipGetDevice(&dev); hipDeviceGetAttribute(&cus, hipDeviceAttributeMultiprocessorCount, dev);
        if (hipFuncSetAttribute((const void*)mega_fwd, hipFuncAttributeMaxDynamicSharedMemorySize, LDS_BYTES) != hipSuccess) { fprintf(stderr, "kernel_launch: hipFuncSetAttribute failed\n"); grid = -1; return; }
        if (hipOccupancyMaxActiveBlocksPerMultiprocessor(&per_cu, (const void*)mega_fwd, NWAVES * 64, LDS_BYTES) != hipSuccess || per_cu < 1) { fprintf(stderr, "kernel_launch: occupancy query says %d\n", per_cu); per_cu = 1; }
        (void)hipGetLastError();
        grid = cus * per_cu;
    }
    if (grid < 0) return;
    Args a{};
    const float** ap = (const float**)&a;
    for (int i = 0; i < 24; ++i) ap[i] = (const float*)d_in[i];
    a.out = (float*)d_out; a.ws = (unsigned char*)d_ws;
    if (hipMemsetAsync((char*)d_ws + WS_BAR, 0, XCD_BAR_WORDS * 4, stream) != hipSuccess) { fprintf(stderr, "kernel_launch: memset of barrier words failed\n"); return; }
#if MK_SINGLE
    a.ph_lo = 0; a.ph_hi = NPH;
    void* args[] = {&a};
    hipError_t e = hipLaunchCooperativeKernel((const void*)mega_fwd, dim3(grid), dim3(NWAVES * 64), args, LDS_BYTES, stream);
    if (e != hipSuccess) fprintf(stderr, "cooperative launch failed: %s (grid %d)\n", hipGetErrorString(e), grid);
#else
    for (int ph = 0; ph < NPH; ++ph) { a.ph_lo = ph; a.ph_hi = ph + 1; hipLaunchKernelGGL(mega_fwd, dim3(grid), dim3(NWAVES * 64), LDS_BYTES, stream, a); }
#endif
}
```
